# Optimizing an MI355X kernel written in HIP

```python
import math
import jax, jax.numpy as jnp
from jax import lax
import numpy as np

D_MODEL = 1024
BATCH = 4
SEQ = 8192
DEPTH = 2

CHUNK = 64
D_MIX = D_MODEL
GLA_HEADS = 4
GLA_DK = 64
GLA_DV = 64
GLA_WIDTH = GLA_HEADS * GLA_DV
GLA_GATE_RANK = 16
GLA_GATE_TAU = 16.0
ATT_HEADS = 8
ATT_DH = 64
ATT_WIDTH = ATT_HEADS * ATT_DH
ATT_LEFT_CHUNKS = 8
ATT_BAND = ATT_LEFT_CHUNKS + 1
REL_CLIP = 256
LRU_WIDTH = D_MIX - GLA_WIDTH - ATT_WIDTH
LRU_BLOCKS = 4
LRU_BLOCK = LRU_WIDTH // LRU_BLOCKS
LRU_C = 8.0
CONV_WIDTH = 4
D_FF = -(-8 * D_MODEL // (3 * 256)) * 256
PLE_DIM = 256
DN_ALPHA = (2 * DEPTH) ** 0.25
DN_BETA = (8 * DEPTH) ** -0.25
LN_EPS = 1e-5
RMS_EPS = 1e-6
NEG_INF = -1e30
IN_SPLITS = [GLA_HEADS * GLA_DK, GLA_HEADS * GLA_DK, GLA_WIDTH, GLA_WIDTH, GLA_GATE_RANK,
             ATT_WIDTH, ATT_WIDTH, ATT_WIDTH, LRU_WIDTH, LRU_WIDTH]
D_IN = sum(IN_SPLITS)

kernel_name = "hymba_style_chunk_causal_hybrid_deepnorm"


def layer_norm(x, g, b):
    xf = x.astype(jnp.float32)
    mu = jnp.mean(xf, axis=-1, keepdims=True)
    var = jnp.mean(jnp.square(xf - mu), axis=-1, keepdims=True)
    return ((xf - mu) * lax.rsqrt(var + LN_EPS) * g.astype(jnp.float32) + b.astype(jnp.float32)).astype(x.dtype)


def gla_mixer(q, k, v, g, lr, w_lr_up, b_lr_up, norm_g):
    dtype = q.dtype
    B, L, _ = q.shape
    NC = L // CHUNK
    f32 = jnp.float32
    log_a = jax.nn.log_sigmoid(lr.astype(f32) @ w_lr_up.astype(f32) + b_lr_up.astype(f32)) / GLA_GATE_TAU
    shp_k = (B, NC, CHUNK, GLA_HEADS, GLA_DK)
    shp_v = (B, NC, CHUNK, GLA_HEADS, GLA_DV)
    log_a = log_a.reshape(shp_k)
    qc = q.astype(f32).reshape(shp_k) * (GLA_DK ** -0.5)
    kc = k.astype(f32).reshape(shp_k)
    vc = v.astype(f32).reshape(shp_v)
    bcum = jnp.cumsum(log_a, axis=2)
    ref = bcum[:, :, CHUNK // 2:CHUNK // 2 + 1]
    causal = jnp.tril(jnp.ones((CHUNK, CHUNK), dtype=bool))
    attn = jnp.einsum('bnihd,bnjhd->bnhij', qc * jnp.exp(bcum - ref), kc * jnp.exp(ref - bcum))
    attn = jnp.where(causal, attn, 0.0)
    o_intra = jnp.einsum('bnhij,bnjhv->bnihv', attn, vc)
    b_last = bcum[:, :, -1]
    u = jnp.einsum('bnjhd,bnjhv->bnhdv', kc * jnp.exp(b_last[:, :, None] - bcum), vc)
    decay = jnp.exp(b_last)

    def step(state, inp):
        d, uc = inp
        return d[..., None] * state + uc, state

    s0 = jnp.zeros((B, GLA_HEADS, GLA_DK, GLA_DV), f32)
    _, s_prev = lax.scan(step, s0, (jnp.swapaxes(decay, 0, 1), jnp.swapaxes(u, 0, 1)))
    s_prev = jnp.swapaxes(s_prev, 0, 1)
    o_inter = jnp.einsum('bnihd,bnhdv->bnihv', qc * jnp.exp(bcum), s_prev)
    o = (o_intra + o_inter).reshape(B, L, GLA_HEADS, GLA_DV)
    o = o * lax.rsqrt(jnp.mean(jnp.square(o), axis=-1, keepdims=True) + RMS_EPS) * norm_g.astype(f32)
    o = o.reshape(B, L, GLA_WIDTH) * jax.nn.silu(g.astype(f32))
    return o.astype(dtype)


def chunk_band_attention(q, k, v, rel_bias):
    B, L, _ = q.shape
    NC = L // CHUNK
    shp = (B, NC, CHUNK, ATT_HEADS, ATT_DH)
    qc = q.reshape(shp) * (ATT_DH ** -0.5)
    pad = ((0, 0), (ATT_LEFT_CHUNKS, 0), (0, 0), (0, 0), (0, 0))
    kp = jnp.pad(k.reshape(shp), pad)
    vp = jnp.pad(v.reshape(shp), pad)
    band_idx = jnp.arange(NC)[:, None] + jnp.arange(ATT_BAND)[None, :]
    q_pos = jnp.arange(CHUNK)
    k_pos = jnp.arange(ATT_BAND * CHUNK) - ATT_LEFT_CHUNKS * CHUNK
    rel_idx = jnp.clip(q_pos[:, None] - k_pos[None, :], -REL_CLIP, REL_CLIP) + REL_CLIP
    bias = rel_bias.astype(jnp.float32)[:, rel_idx]
    valid = (jnp.arange(NC)[:, None] - ATT_LEFT_CHUNKS + jnp.arange(ATT_BAND)[None, :]) >= 0
    valid = jnp.repeat(valid, CHUNK, axis=1)

    def one_sequence(args):
        qb, kb, vb = args
        kband = kb[band_idx].reshape(NC, ATT_BAND * CHUNK, ATT_HEADS, ATT_DH)
        vband = vb[band_idx].reshape(NC, ATT_BAND * CHUNK, ATT_HEADS, ATT_DH)
        s = jnp.einsum('nqhd,nkhd->hnqk', qb, kband).astype(jnp.float32) + bias[:, None]
        s = jnp.where(valid[None, :, None, :], s, NEG_INF)
        w = jax.nn.softmax(s, axis=-1).astype(vb.dtype)
        return jnp.einsum('hnqk,nkhd->nqhd', w, vband)

    o = lax.map(one_sequence, (qc, kp, vp))
    return o.reshape(B, L, ATT_WIDTH)


def rg_lru_mixer(xb, gb, conv_w, conv_b, w_a, b_a, w_i, b_i, lam):
    dtype = xb.dtype
    B, L, _ = xb.shape
    f32 = jnp.float32
    xc = lax.conv_general_dilated(xb, conv_w[:, None, :], (1,), [(CONV_WIDTH - 1, 0)],
                                  dimension_numbers=('NWC', 'WIO', 'NWC'),
                                  feature_group_count=LRU_WIDTH) + conv_b
    xblk = xc.reshape(B, L, LRU_BLOCKS, LRU_BLOCK)
    r = jax.nn.sigmoid(jnp.einsum('blgc,gcd->blgd', xblk, w_a).astype(f32)
                       + b_a.astype(f32).reshape(LRU_BLOCKS, LRU_BLOCK)).reshape(B, L, LRU_WIDTH)
    i = jax.nn.sigmoid(jnp.einsum('blgc,gcd->blgd', xblk, w_i).astype(f32)
                       + b_i.astype(f32).reshape(LRU_BLOCKS, LRU_BLOCK)).reshape(B, L, LRU_WIDTH)
    log_a = -LRU_C * r * jax.nn.softplus(-lam.astype(f32))
    a = jnp.exp(log_a)
    u = jnp.sqrt(-jnp.expm1(2.0 * log_a)) * (i * xc.astype(f32))

    def combine(c1, c2):
        a1, b1 = c1
        a2, b2 = c2
        return a1 * a2, a2 * b1 + b2

    _, h = lax.associative_scan(combine, (a, u), axis=1)
    return (h * jax.nn.gelu(gb.astype(f32))).astype(dtype)


def hybrid_layer(x, p_i, w_in, gla_w_lr_up, gla_b_lr_up, gla_norm_g, rel_bias,
                 lru_conv_w, lru_conv_b, lru_w_a, lru_b_a, lru_w_i, lru_b_i, lru_lambda,
                 w_out, ln1_g, ln1_b, w_ffn_gate, w_ffn_up, w_ffn_down,
                 w_ple_gate, w_ple_proj, ln2_g, ln2_b):
    h = x @ w_in
    offs = np.cumsum(IN_SPLITS)[:-1].tolist()
    (gq, gk, gv, gg, glr, aq, ak, av, lx, lg) = jnp.split(h, offs, axis=-1)
    y_gla = gla_mixer(gq, gk, gv, gg, glr, gla_w_lr_up, gla_b_lr_up, gla_norm_g)
    y_att = chunk_band_attention(aq, ak, av, rel_bias)
    y_lru = rg_lru_mixer(lx, lg, lru_conv_w, lru_conv_b, lru_w_a, lru_b_a, lru_w_i, lru_b_i, lru_lambda)
    mix = jnp.concatenate([y_gla, y_att, y_lru], axis=-1) @ w_out
    x = layer_norm(DN_ALPHA * x + mix, ln1_g, ln1_b)
    ffn = (jax.nn.silu(x @ w_ffn_gate) * (x @ w_ffn_up)) @ w_ffn_down
    ple = jax.nn.sigmoid(x @ w_ple_gate) * (p_i @ w_ple_proj)
    return layer_norm(DN_ALPHA * x + ffn + ple, ln2_g, ln2_b)


def setup_inputs(seed: int = 0) -> dict:
    key = jax.random.key(seed)
    ks = jax.random.split(key, 24)
    f32 = jnp.float32

    def nrm(k, shape, scale):
        return jax.random.normal(k, shape, f32) * scale

    u = jax.random.uniform(ks[11], (DEPTH, LRU_WIDTH), f32, 0.9, 0.999)
    s = u ** (1.0 / LRU_C)
    lru_lambda = jnp.log(s) - jnp.log1p(-s)
    return {
        "x": nrm(ks[0], (BATCH, SEQ, D_MODEL), 1.0),
        "p": nrm(ks[1], (DEPTH, BATCH, SEQ, PLE_DIM), 1.0),
        "w_in": nrm(ks[2], (DEPTH, D_MODEL, D_IN), D_MODEL ** -0.5),
        "gla_w_lr_up": nrm(ks[3], (DEPTH, GLA_GATE_RANK, GLA_HEADS * GLA_DK), GLA_GATE_RANK ** -0.5),
        "gla_b_lr_up": nrm(ks[4], (DEPTH, GLA_HEADS * GLA_DK), 0.1),
        "gla_norm_g": 1.0 + nrm(ks[5], (DEPTH, GLA_DV), 0.02),
        "rel_bias": nrm(ks[6], (ATT_HEADS, 2 * REL_CLIP + 1), 0.1),
        "lru_conv_w": nrm(ks[7], (DEPTH, CONV_WIDTH, LRU_WIDTH), CONV_WIDTH ** -0.5),
        "lru_conv_b": nrm(ks[8], (DEPTH, LRU_WIDTH), 0.01),
        "lru_w_a": nrm(ks[9], (DEPTH, LRU_BLOCKS, LRU_BLOCK, LRU_BLOCK), LRU_BLOCK ** -0.5),
        "lru_b_a": nrm(ks[10], (DEPTH, LRU_WIDTH), 0.01),
        "lru_w_i": nrm(ks[12], (DEPTH, LRU_BLOCKS, LRU_BLOCK, LRU_BLOCK), LRU_BLOCK ** -0.5),
        "lru_b_i": nrm(ks[13], (DEPTH, LRU_WIDTH), 0.01),
        "lru_lambda": lru_lambda,
        "w_out": nrm(ks[14], (DEPTH, D_MIX, D_MODEL), D_MIX ** -0.5 * DN_BETA),
        "ln1_g": 1.0 + nrm(ks[15], (DEPTH, D_MODEL), 0.02),
        "ln1_b": nrm(ks[16], (DEPTH, D_MODEL), 0.02),
        "w_ffn_gate": nrm(ks[17], (DEPTH, D_MODEL, D_FF), D_MODEL ** -0.5),
        "w_ffn_up": nrm(ks[18], (DEPTH, D_MODEL, D_FF), D_MODEL ** -0.5),
        "w_ffn_down": nrm(ks[19], (DEPTH, D_FF, D_MODEL), D_FF ** -0.5 * DN_BETA),
        "w_ple_gate": nrm(ks[20], (DEPTH, D_MODEL, D_MODEL), D_MODEL ** -0.5),
        "w_ple_proj": nrm(ks[21], (DEPTH, PLE_DIM, D_MODEL), PLE_DIM ** -0.5 * DN_BETA),
        "ln2_g": 1.0 + nrm(ks[22], (DEPTH, D_MODEL), 0.02),
        "ln2_b": nrm(ks[23], (DEPTH, D_MODEL), 0.02),
    }


def reference(x, p, w_in, gla_w_lr_up, gla_b_lr_up, gla_norm_g, rel_bias,
              lru_conv_w, lru_conv_b, lru_w_a, lru_b_a, lru_w_i, lru_b_i, lru_lambda,
              w_out, ln1_g, ln1_b, w_ffn_gate, w_ffn_up, w_ffn_down,
              w_ple_gate, w_ple_proj, ln2_g, ln2_b):
    for i in range(DEPTH):
        x = hybrid_layer(x, p[i], w_in[i], gla_w_lr_up[i], gla_b_lr_up[i], gla_norm_g[i], rel_bias,
                         lru_conv_w[i], lru_conv_b[i], lru_w_a[i], lru_b_a[i], lru_w_i[i], lru_b_i[i],
                         lru_lambda[i], w_out[i], ln1_g[i], ln1_b[i], w_ffn_gate[i], w_ffn_up[i],
                         w_ffn_down[i], w_ple_gate[i], w_ple_proj[i], ln2_g[i], ln2_b[i])
    return x
```

```cpp
#include <hip/hip_runtime.h>
#include <hip/hip_cooperative_groups.h>
#include <cstdio>
namespace cg = cooperative_groups;

constexpr int T_TOK = 32768, SEQ = 8192, NB = 4, NCH = 128, DM = 1024, DINP = 3328, DFF = 2816, PLE = 256;
constexpr float DN_ALPHA = 1.41421356237309515f;
constexpr size_t SZ_WIN = (size_t)DINP * DM * 2, SZ_WOUT = (size_t)DM * DM * 2, SZ_WGU = (size_t)2 * DFF * DM * 2, SZ_WDN = (size_t)DM * DFF * 2, SZ_WPG = (size_t)DM * DM * 2, SZ_WPP = (size_t)DM * PLE * 2;
constexpr size_t WS_WIN = 0;
constexpr size_t WS_WOUT = WS_WIN + 2 * SZ_WIN;
constexpr size_t WS_WGU = WS_WOUT + 2 * SZ_WOUT;
constexpr size_t WS_WDN = WS_WGU + 2 * SZ_WGU;
constexpr size_t WS_WPG = WS_WDN + 2 * SZ_WDN;
constexpr size_t WS_WPP = WS_WPG + 2 * SZ_WPG;
constexpr size_t WS_XB = WS_WPP + 2 * SZ_WPP;
constexpr size_t WS_PB = WS_XB + (size_t)T_TOK * DM * 2;
constexpr size_t WS_R1 = WS_PB + (size_t)T_TOK * PLE * 2;
constexpr size_t WS_X1 = WS_R1 + (size_t)T_TOK * DINP * 2;
constexpr size_t WS_SM = WS_X1 + (size_t)T_TOK * DM * 4;
constexpr size_t WS_END = WS_SM + 4 * 524288;
constexpr size_t X1_VT = 0, X1_U = (size_t)T_TOK * 512 * 2;

typedef unsigned short bf16_t;
typedef unsigned u32x4 __attribute__((ext_vector_type(4)));
typedef unsigned u32x2 __attribute__((ext_vector_type(2)));

__device__ __forceinline__ bf16_t f2bf(float f) { unsigned u = __float_as_uint(f); u += 0x7FFFu + ((u >> 16) & 1u); return (bf16_t)(u >> 16); }
__device__ __forceinline__ float bf2f(bf16_t b) { return __uint_as_float(((unsigned)b) << 16); }
__device__ __forceinline__ unsigned pack2(float lo, float hi) { return (unsigned)f2bf(lo) | ((unsigned)f2bf(hi) << 16); }
__device__ __forceinline__ float bflo(unsigned w) { return __uint_as_float(w << 16); }
__device__ __forceinline__ float bfhi(unsigned w) { return __uint_as_float(w & 0xFFFF0000u); }
__device__ __forceinline__ float sigmoidf_(float x) { return 1.0f / (1.0f + __expf(-x)); }
__device__ __forceinline__ float siluf_(float x) { return x / (1.0f + __expf(-x)); }
__device__ __forceinline__ float gelu_tanh(float x) { const float u = 0.7978845608028654f * (x + 0.044715f * x * x * x); const float e = __expf(2.0f * u); const float th = 1.0f - 2.0f / (e + 1.0f); return 0.5f * x * (1.0f + th); }

struct Params { const float* in[24]; float* out; unsigned char* ws; };


__device__ __forceinline__ int ltid() { int t = threadIdx.x; asm volatile("" : "+v"(t)); return t; }
__device__ __forceinline__ int lbid() { int t = blockIdx.x; asm volatile("" : "+s"(t)); return t; }
__device__ __forceinline__ Params fresh_params() {
    const __attribute__((address_space(4))) Params* kp = (const __attribute__((address_space(4))) Params*)__builtin_amdgcn_kernarg_segment_ptr();
    asm volatile("" : "+s"(kp)); Params r;
#pragma unroll
    for (int i = 0; i < 24; ++i) r.in[i] = kp->in[i];
    r.out = kp->out; r.ws = kp->ws; return r; }
namespace pg8 {
#define PG8_LAS __attribute__((address_space(3)))
typedef unsigned short bf16_t;
typedef short bf16x8 __attribute__((ext_vector_type(8)));
typedef float f32x4 __attribute__((ext_vector_type(4)));
typedef unsigned u32x4 __attribute__((ext_vector_type(4)));
constexpr int BM = 256, BK = 64, HALF = 128, HTB = HALF * BK * 2  , STAGE_BYTES = 8 * HTB, NXCD = 8, WGM = 8;

__host__ __device__ __forceinline__ int lds_byte(int r, int c) { const int st = (r >> 4) * 2 + (c >> 5), rr = r & 15, cc = c & 31, ob = rr * 64 + cc * 2; return st * 1024 + (ob ^ (((ob >> 9) & 1) << 5)); }
__host__ __device__ __forceinline__ void stage_rc(int b, int& R, int& C) { const int st = b / 1024, sb = b % 1024, swz = sb ^ (((sb >> 9) & 1) << 5); R = (st >> 1) * 16 + swz / 64; C = (st & 1) * 32 + (swz % 64) / 2; }
__host__ __device__ __forceinline__ int perm32(int rho) { const int n = rho >> 4, i = rho & 15; return 8 * (i >> 2) + 4 * n + (i & 3); }

struct Unit { int pm, pn; };
struct Gemm { const bf16_t* A; const bf16_t* Bt; int M, N, K; };

struct StaticOrder {
    int nM, nN, nwg, G, c;
    __host__ __device__ void init(int M, int N, int G_, int c_) { nM = M / BM; nN = N / BM; nwg = nM * nN; G = G_; c = c_; }
    __host__ __device__ bool next(int i, Unit& u) const {
        const long L = (long)i * G + c; if (L >= nwg) return false;
        int wgid = (int)L; { const int q = nwg / NXCD, r = nwg % NXCD, xcd = wgid % NXCD, off = wgid / NXCD; wgid = (xcd < r ? xcd * (q + 1) : r * (q + 1) + (xcd - r) * q) + off; }
        const int nig = WGM * nN, gid = wgid / nig, fm = gid * WGM, gsz = (nM - fm) < WGM ? (nM - fm) : WGM;
        u.pm = fm + ((wgid % nig) % gsz); u.pn = (wgid % nig) / gsz; return true;
    }
    __device__ __forceinline__ void a_ready(const Unit&) const {}
    __device__ __forceinline__ void done(const Unit&) const {}
};
__device__ __forceinline__ unsigned cvt_pk_bf16(float lo, float hi) { unsigned r; asm volatile("v_cvt_pk_bf16_f32 %0, %1, %2" : "=v"(r) : "v"(lo), "v"(hi)); return r; }
typedef float f32x2 __attribute__((ext_vector_type(2)));
template <class Epi, class Sched, bool STAMP = false>
__device__ __forceinline__ void gemm_phase(PG8_LAS unsigned char* lds, const Gemm g, const Sched& S, const Epi& E, unsigned long long* stamps) {
    const int tid = ltid(), wid = __builtin_amdgcn_readfirstlane(tid >> 6), lane = tid & 63, wr = wid >> 2, wc = wid & 3, fr = lane & 15, fq = lane >> 4;
    const int K = g.K, nt = K / BK;
    int ts_lo = 0, ts_hi = 0, nts = 0; const unsigned long long rt_entry = STAMP ? (unsigned long long)wall_clock64() : 0ull;
#define PG8_STAMP() do { if (STAMP && wid == 0 && nts < 64) { const unsigned long long _c = (unsigned long long)clock64(); \
        ts_lo = (lane == nts) ? (int)(unsigned)_c : ts_lo; ts_hi = (lane == nts) ? (int)(unsigned)(_c >> 32) : ts_hi; ++nts; } } while (0)
    PG8_STAMP();
    unsigned voffA[2], voffB[2];
#pragma unroll
    for (int i = 0; i < 2; ++i) { int R, C; stage_rc(tid * 16 + i * 8192, R, C); const int Rb = Epi::PERM ? ((R & ~31) + perm32(R & 31)) : R;
        voffA[i] = (unsigned)(R * K + C) * 2u; voffB[i] = (unsigned)(Rb * K + C) * 2u; }
    const size_t kstep = (size_t)(BK * 2);
    const size_t hstep = (size_t)HALF * K * 2;
    const size_t tstep = 2 * hstep;
    const unsigned ldsw = (unsigned)wid * 1024u;
    const int aoff = lds_byte(wr * 64 + fr, fq * 8), boff = lds_byte(wc * 32 + fr, fq * 8);
#define PG8_SA(b, h) (((b) * 2 + (h)) * HTB)
#define PG8_SB(b, h) ((4 + (b) * 2 + (h)) * HTB)
#define PG8_STAGE(bufoff, gbase, voff) do { _Pragma("unroll") for (int _i = 0; _i < 2; ++_i) \
        __builtin_amdgcn_global_load_lds((const unsigned*)((const char*)(gbase) + (voff)[_i]), (PG8_LAS unsigned*)(lds + (bufoff) + ldsw + _i * 8192), 16, 0, 0); } while (0)
#define PG8_LDA(dst, b, h) do { _Pragma("unroll") for (int m = 0; m < 4; ++m) _Pragma("unroll") for (int k = 0; k < 2; ++k) dst[m][k] = *(const PG8_LAS bf16x8*)(lds + PG8_SA(b, h) + aoff + m * 2048 + k * 1024); } while (0)
#define PG8_LDB(dst, b, h) do { _Pragma("unroll") for (int n = 0; n < 2; ++n) _Pragma("unroll") for (int k = 0; k < 2; ++k) dst[n][k] = *(const PG8_LAS bf16x8*)(lds + PG8_SB(b, h) + boff + n * 2048 + k * 1024); } while (0)
#define PG8_MMA(ai, bj, At, Bt) do { __builtin_amdgcn_s_setprio(1); _Pragma("unroll") for (int m = 0; m < 4; ++m) _Pragma("unroll") for (int n = 0; n < 2; ++n) _Pragma("unroll") for (int k = 0; k < 2; ++k) \
        acc[ai][bj][m][n] = __builtin_amdgcn_mfma_f32_16x16x32_bf16(Bt[n][k], At[m][k], acc[ai][bj][m][n], 0, 0, 0); __builtin_amdgcn_s_setprio(0); } while (0)
#define PG8_WAIT_V(n) asm volatile("s_waitcnt vmcnt(" #n ")" ::: "memory")
#define PG8_WAIT_L(n) asm volatile("s_waitcnt lgkmcnt(" #n ")" ::: "memory")
#define PG8_BAR __builtin_amdgcn_s_barrier()
#define PG8_SCHED __builtin_amdgcn_sched_barrier(0)
    Unit cur, nxt; int ui = 0;
    if (!S.next(0, cur)) return;
    f32x4 acc[2][2][4][2];
#pragma unroll
    for (int a = 0; a < 2; ++a)
#pragma unroll
        for (int b = 0; b < 2; ++b)
#pragma unroll
            for (int m = 0; m < 4; ++m)
#pragma unroll
                for (int n = 0; n < 2; ++n) acc[a][b][m][n] = (f32x4){0.f, 0.f, 0.f, 0.f};
    bf16x8 At[4][2], B0[2][2], B1[2][2];
    const char* cA = (const char*)g.A + (size_t)cur.pm * tstep; const char* cB = (const char*)g.Bt + (size_t)cur.pn * tstep;
    S.a_ready(cur);
    PG8_STAGE(PG8_SB(0, 0), cB, voffB); PG8_STAGE(PG8_SA(0, 0), cA, voffA); PG8_STAGE(PG8_SB(0, 1), cB + hstep, voffB); PG8_STAGE(PG8_SA(0, 1), cA + hstep, voffA);
    if (wr == 1) PG8_BAR;
    PG8_WAIT_V(4); PG8_BAR;
    PG8_STAGE(PG8_SB(1, 0), cB + kstep, voffB); PG8_STAGE(PG8_SA(1, 0), cA + kstep, voffA); PG8_STAGE(PG8_SB(1, 1), cB + hstep + kstep, voffB);
    PG8_WAIT_V(6); PG8_BAR;
    PG8_STAMP();
    for (;;) {
        const bool has_next = S.next(ui + 1, nxt);
        const char* nA = has_next ? (const char*)g.A + (size_t)nxt.pm * tstep : cA; const char* nB = has_next ? (const char*)g.Bt + (size_t)nxt.pn * tstep : cB;
        for (int t = 0; t < nt; t += 2) {
            const bool last = (t == nt - 2);
            const char* a1 = cA + (size_t)(t + 1) * kstep;
            const char* a2 = last ? nA : cA + (size_t)(t + 2) * kstep; const char* b2 = last ? nB : cB + (size_t)(t + 2) * kstep;
            const char* a3 = a2 + kstep; const char* b3 = b2 + kstep;
            if (last && has_next) S.a_ready(nxt);
            PG8_LDB(B0, 0, 0); PG8_SCHED; PG8_LDA(At, 0, 0); PG8_STAGE(PG8_SA(1, 1), a1 + hstep, voffA);
            PG8_WAIT_L(8); PG8_BAR; PG8_WAIT_L(0); PG8_MMA(0, 0, At, B0); PG8_BAR; PG8_SCHED;
            PG8_LDB(B1, 0, 1); PG8_STAGE(PG8_SB(0, 0), b2, voffB);
            PG8_BAR; PG8_WAIT_L(0); PG8_MMA(0, 1, At, B1); PG8_BAR;
            PG8_LDA(At, 0, 1); PG8_STAGE(PG8_SA(0, 0), a2, voffA);
            PG8_BAR; PG8_WAIT_L(0); PG8_MMA(1, 0, At, B0); PG8_BAR; PG8_SCHED;
            PG8_STAGE(PG8_SB(0, 1), b2 + hstep, voffB);
            PG8_WAIT_V(6); PG8_BAR; PG8_MMA(1, 1, At, B1); PG8_BAR;
            PG8_LDB(B0, 1, 0); PG8_SCHED; PG8_LDA(At, 1, 0); PG8_STAGE(PG8_SA(0, 1), a2 + hstep, voffA);
            PG8_WAIT_L(8); PG8_BAR; PG8_WAIT_L(0); PG8_MMA(0, 0, At, B0); PG8_BAR; PG8_SCHED;
            PG8_LDB(B1, 1, 1); PG8_STAGE(PG8_SB(1, 0), b3, voffB);
            PG8_BAR; PG8_WAIT_L(0); PG8_MMA(0, 1, At, B1); PG8_BAR;
            PG8_LDA(At, 1, 1); PG8_STAGE(PG8_SA(1, 0), a3, voffA);
            PG8_BAR; PG8_WAIT_L(0); PG8_MMA(1, 0, At, B0); PG8_BAR; PG8_SCHED;
            PG8_STAGE(PG8_SB(1, 1), b3 + hstep, voffB);
            PG8_WAIT_V(6); PG8_BAR; PG8_MMA(1, 1, At, B1); PG8_BAR;
        }
        PG8_STAMP();
        if constexpr (!Epi::AFTER_DRAIN) { E(acc, cur, wr, wc, fr, fq); S.done(cur); }
        PG8_STAMP();
        if (!has_next) break;
#pragma unroll
        for (int a = 0; a < 2; ++a)
#pragma unroll
            for (int b = 0; b < 2; ++b)
#pragma unroll
                for (int m = 0; m < 4; ++m)
#pragma unroll
                    for (int n = 0; n < 2; ++n) acc[a][b][m][n] = (f32x4){0.f, 0.f, 0.f, 0.f};
        cur = nxt; cA = nA; cB = nB; ++ui;
    }
    PG8_WAIT_V(0);
    if (wr == 0) PG8_BAR;
    PG8_BAR;
    if constexpr (Epi::AFTER_DRAIN) { E.fused(acc, cur, wr, wc, fr, fq, lds, wid, lane); S.done(cur); }
    PG8_STAMP();
    if (STAMP && wid == 0) { stamps[lane] = lane < nts ? (((unsigned long long)(unsigned)ts_hi << 32) | (unsigned)ts_lo) : 0ull;
        if (lane == 62) stamps[62] = rt_entry; if (lane == 63) stamps[63] = (unsigned long long)wall_clock64(); }
#undef PG8_STAMP
#undef PG8_SA
#undef PG8_SB
#undef PG8_STAGE
#undef PG8_LDA
#undef PG8_LDB
#undef PG8_MMA
#undef PG8_WAIT_V
#undef PG8_WAIT_L
#undef PG8_BAR
#undef PG8_SCHED
}
}

using pg8::bf16x8; using pg8::f32x4; using pg8::Unit;
#define LAS __attribute__((address_space(3)))

struct EpiStoreBf16 {
    static constexpr bool PERM = true, AFTER_DRAIN = false;
    bf16_t* O; int ldc;
    __device__ __forceinline__ void operator()(const f32x4 (&acc)[2][2][4][2], const Unit& u, int wr, int wc, int fr, int fq) const {
        const int row0 = u.pm * 256 + wr * 64 + fr, col0 = u.pn * 256 + wc * 32 + 8 * fq;
#pragma unroll
        for (int ai = 0; ai < 2; ++ai)
#pragma unroll
            for (int m = 0; m < 4; ++m) { bf16_t* rowp = O + (size_t)(row0 + ai * 128 + m * 16) * ldc + col0;
#pragma unroll
                for (int bj = 0; bj < 2; ++bj) { const f32x4 v0 = acc[ai][bj][m][0], v1 = acc[ai][bj][m][1];
                    u32x4 o; o.x = pg8::cvt_pk_bf16(v0[0], v0[1]); o.y = pg8::cvt_pk_bf16(v0[2], v0[3]); o.z = pg8::cvt_pk_bf16(v1[0], v1[1]); o.w = pg8::cvt_pk_bf16(v1[2], v1[3]);
                    *(u32x4*)(rowp + bj * 128) = o; } }
    }
};
struct EpiSwiGLU {
    static constexpr bool PERM = true, AFTER_DRAIN = false;
    bf16_t* O;
    __device__ __forceinline__ void operator()(const f32x4 (&acc)[2][2][4][2], const Unit& u, int wr, int wc, int fr, int fq) const {
        const int row0 = u.pm * 256 + wr * 64 + fr, col0 = u.pn * 128 + wc * 32 + 8 * fq;
#pragma unroll
        for (int ai = 0; ai < 2; ++ai)
#pragma unroll
            for (int m = 0; m < 4; ++m) { bf16_t* rowp = O + (size_t)(row0 + ai * 128 + m * 16) * DFF + col0;
                float h[8];
#pragma unroll
                for (int n = 0; n < 2; ++n)
#pragma unroll
                    for (int j = 0; j < 4; ++j) h[n * 4 + j] = siluf_(acc[ai][0][m][n][j]) * acc[ai][1][m][n][j];
                u32x4 o; o.x = pg8::cvt_pk_bf16(h[0], h[1]); o.y = pg8::cvt_pk_bf16(h[2], h[3]); o.z = pg8::cvt_pk_bf16(h[4], h[5]); o.w = pg8::cvt_pk_bf16(h[6], h[7]);
                *(u32x4*)rowp = o; }
    }
};
template <int MODE> struct EpiF32 {
    static constexpr bool PERM = false, AFTER_DRAIN = false;
    float* C; const float* R; const float* P;
    __device__ __forceinline__ void operator()(const f32x4 (&acc)[2][2][4][2], const Unit& u, int wr, int wc, int fr, int fq) const {
        const int row0 = u.pm * 256 + wr * 64 + fr, col0 = u.pn * 256 + wc * 32 + 4 * fq;
#pragma unroll
        for (int ai = 0; ai < 2; ++ai)
#pragma unroll
            for (int m = 0; m < 4; ++m) { const size_t rb = (size_t)(row0 + ai * 128 + m * 16) * DM + col0;
#pragma unroll
                for (int bj = 0; bj < 2; ++bj)
#pragma unroll
                    for (int n = 0; n < 2; ++n) { const size_t idx = rb + bj * 128 + n * 16; const f32x4 a = acc[ai][bj][m][n]; f32x4 o;
                        if (MODE == 0) { const f32x4 r = *(const f32x4*)(R + idx); o = r * DN_ALPHA + a; }
                        else if (MODE == 1) { o[0] = sigmoidf_(a[0]); o[1] = sigmoidf_(a[1]); o[2] = sigmoidf_(a[2]); o[3] = sigmoidf_(a[3]); }
                        else if (MODE == 2) { const f32x4 c = *(const f32x4*)(C + idx); o = c * a; }
                        else { const f32x4 r = *(const f32x4*)(R + idx); const f32x4 pp = *(const f32x4*)(P + idx); o = r * DN_ALPHA + a + pp; }
                        *(f32x4*)(C + idx) = o; } }
    }
};

template <class Epi> __device__ __forceinline__ void run_gemm(unsigned char* lds, const bf16_t* A, const bf16_t* Bt, int N, int K, const Epi& E) {
    pg8::Gemm g; g.A = A; g.Bt = Bt; g.M = T_TOK; g.N = N; g.K = K;
    pg8::StaticOrder S; S.init(T_TOK, N, (int)gridDim.x, lbid());
    pg8::gemm_phase<Epi, pg8::StaticOrder, false>((LAS unsigned char*)lds, g, S, E, nullptr);
    __syncthreads();
}

__device__ __forceinline__ int map_col(int n, int mode) {
    if (mode == 1) return n < 1024 ? n : (n < 1040 ? n - 1024 + 3072 : n - 16);
    if (mode == 2) return (n >> 7) * 256 + (n & 127);
    if (mode == 3) return (n >> 7) * 256 + 128 + (n & 127);
    return n;
}
__device__ __forceinline__ void transpose_job(const float* __restrict__ src, bf16_t* __restrict__ dst, int K, int N, int mode, float* tile, int& base) {
    const int tid = ltid(), G = gridDim.x;
    const int ntn = (N + 63) >> 6, ntile = (K >> 6) * ntn;
    int t0 = ((int)blockIdx.x - (base % G) + G) % G;
    for (int t = t0; t < ntile; t += G) {
        const int k0 = (t / ntn) << 6, n0 = (t % ntn) << 6;
#pragma unroll
        for (int i = 0; i < 2; ++i) { const int kk = (tid >> 4) + 32 * i, nn = (tid & 15) * 4;
#pragma unroll
            for (int j = 0; j < 4; ++j) { const int n = n0 + nn + j; tile[kk * 65 + nn + j] = (n < N) ? src[(size_t)(k0 + kk) * N + n] : 0.f; } }
        __syncthreads();
        { const int nn = tid >> 3, ks = (tid & 7) * 8, n = n0 + nn;
          if (n < N) { u32x4 o;
              o.x = pack2(tile[(ks + 0) * 65 + nn], tile[(ks + 1) * 65 + nn]); o.y = pack2(tile[(ks + 2) * 65 + nn], tile[(ks + 3) * 65 + nn]);
              o.z = pack2(tile[(ks + 4) * 65 + nn], tile[(ks + 5) * 65 + nn]); o.w = pack2(tile[(ks + 6) * 65 + nn], tile[(ks + 7) * 65 + nn]);
              *(u32x4*)(dst + (size_t)map_col(n, mode) * K + k0 + ks) = o; } }
        __syncthreads();
    }
    base += ntile;
}
__device__ __forceinline__ void cvt_rows_bf16(const float* __restrict__ src, bf16_t* __restrict__ dst, size_t n8) {
    for (size_t i = (size_t)lbid() * 512 + ltid(); i < n8; i += (size_t)gridDim.x * 512) {
        const f32x4 a = *(const f32x4*)(src + i * 8), b = *(const f32x4*)(src + i * 8 + 4);
        u32x4 o; o.x = pack2(a[0], a[1]); o.y = pack2(a[2], a[3]); o.z = pack2(b[0], b[1]); o.w = pack2(b[2], b[3]);
        *(u32x4*)(dst + i * 8) = o; }
}
__device__ __forceinline__ void prologue_phase(const Params& p, unsigned char* lds) {
    float* tile = (float*)lds; unsigned char* ws = p.ws; int base = 0;
    for (int l = 0; l < 2; ++l) {
        transpose_job(p.in[2] + (size_t)l * DM * 3088, (bf16_t*)(ws + WS_WIN + l * SZ_WIN), DM, 3088, 1, tile, base);
        transpose_job(p.in[14] + (size_t)l * DM * DM, (bf16_t*)(ws + WS_WOUT + l * SZ_WOUT), DM, DM, 0, tile, base);
        transpose_job(p.in[17] + (size_t)l * DM * DFF, (bf16_t*)(ws + WS_WGU + l * SZ_WGU), DM, DFF, 2, tile, base);
        transpose_job(p.in[18] + (size_t)l * DM * DFF, (bf16_t*)(ws + WS_WGU + l * SZ_WGU), DM, DFF, 3, tile, base);
        transpose_job(p.in[19] + (size_t)l * DFF * DM, (bf16_t*)(ws + WS_WDN + l * SZ_WDN), DFF, DM, 0, tile, base);
        transpose_job(p.in[20] + (size_t)l * DM * DM, (bf16_t*)(ws + WS_WPG + l * SZ_WPG), DM, DM, 0, tile, base);
        transpose_job(p.in[21] + (size_t)l * PLE * DM, (bf16_t*)(ws + WS_WPP + l * SZ_WPP), PLE, DM, 0, tile, base);
        u32x4* z = (u32x4*)(ws + WS_WIN + l * SZ_WIN + (size_t)3088 * DM * 2);
        for (int i = lbid() * 512 + ltid(); i < 240 * DM / 8; i += gridDim.x * 512) z[i] = (u32x4){0u, 0u, 0u, 0u};
    }
    cvt_rows_bf16(p.in[0], (bf16_t*)(ws + WS_XB), (size_t)T_TOK * DM / 8);
}

__device__ __forceinline__ float wave_sum(float v) {
#pragma unroll
    for (int o = 32; o > 0; o >>= 1) v += __shfl_xor(v, o, 64);
    return v;
}
__device__ __forceinline__ void ln_phase(const float* zin, float* xout, bf16_t* xb, const float* __restrict__ g, const float* __restrict__ bta) {
    const int tid_ = ltid(); const int lane = tid_ & 63, wave = tid_ >> 6;
    for (int row = lbid() * 8 + wave; row < T_TOK; row += gridDim.x * 8) {
        const f32x4* zr = (const f32x4*)(zin + (size_t)row * DM);
        f32x4 v[4]; float s = 0.f;
#pragma unroll
        for (int i = 0; i < 4; ++i) { v[i] = zr[lane + 64 * i]; s += v[i][0] + v[i][1] + v[i][2] + v[i][3]; }
        const float mean = wave_sum(s) * (1.0f / DM);
        float q = 0.f;
#pragma unroll
        for (int i = 0; i < 4; ++i) { v[i] = v[i] - mean; q += v[i][0] * v[i][0] + v[i][1] * v[i][1] + v[i][2] * v[i][2] + v[i][3] * v[i][3]; }
        const float rstd = 1.0f / sqrtf(wave_sum(q) * (1.0f / DM) + 1e-5f);
#pragma unroll
        for (int i = 0; i < 4; ++i) { const f32x4 gg = ((const f32x4*)g)[lane + 64 * i], bb = ((const f32x4*)bta)[lane + 64 * i];
            const f32x4 o = v[i] * rstd * gg + bb;
            ((f32x4*)(xout + (size_t)row * DM))[lane + 64 * i] = o;
            if (xb) { u32x2 w; w.x = pack2(o[0], o[1]); w.y = pack2(o[2], o[3]); ((u32x2*)(xb + (size_t)row * DM))[lane + 64 * i] = w; } }
    }
}

constexpr int LDP = 72;
__device__ __forceinline__ f32x4 mma16(const bf16_t* A, int arow0, const bf16_t* Bt, int brow0, int ksteps, f32x4 acc, int lane) {
    const int r = lane & 15, g = lane >> 4;
    for (int kk = 0; kk < ksteps; ++kk) {
        const bf16x8 a = *(const bf16x8*)(A + (arow0 + r) * LDP + kk * 32 + g * 8);
        const bf16x8 b = *(const bf16x8*)(Bt + (brow0 + r) * LDP + kk * 32 + g * 8);
        acc = __builtin_amdgcn_mfma_f32_16x16x32_bf16(a, b, acc, 0, 0, 0);
    }
    return acc;
}

__device__ __forceinline__ void vtrans_item(int b, int n, const bf16_t* H, bf16_t* vT, unsigned char* lds) {
    bf16_t* TT = (bf16_t*)lds;
    const int tid = ltid(); const size_t tok0 = (size_t)b * SEQ + (size_t)n * 64;
#pragma unroll
    for (int i = 0; i < 8; ++i) { const int vid = tid + 512 * i, t = vid & 63, cs = (vid >> 6) * 8;
        const u32x4 w = *(const u32x4*)(H + (tok0 + t) * DINP + 2048 + cs);
        TT[(cs + 0) * LDP + t] = (bf16_t)(w.x & 0xFFFFu); TT[(cs + 1) * LDP + t] = (bf16_t)(w.x >> 16);
        TT[(cs + 2) * LDP + t] = (bf16_t)(w.y & 0xFFFFu); TT[(cs + 3) * LDP + t] = (bf16_t)(w.y >> 16);
        TT[(cs + 4) * LDP + t] = (bf16_t)(w.z & 0xFFFFu); TT[(cs + 5) * LDP + t] = (bf16_t)(w.z >> 16);
        TT[(cs + 6) * LDP + t] = (bf16_t)(w.w & 0xFFFFu); TT[(cs + 7) * LDP + t] = (bf16_t)(w.w >> 16); }
    __syncthreads();
#pragma unroll
    for (int i = 0; i < 8; ++i) { const int vid = tid + 512 * i, col = vid >> 3, ts = (vid & 7) * 8;
        const u32x4 w = *(const u32x4*)(TT + col * LDP + ts);
        *(u32x4*)(vT + ((size_t)b * 512 + col) * SEQ + (size_t)n * 64 + ts) = w; }
    __syncthreads();
}

__device__ __forceinline__ void gla_item(int mode, int b, int n, int h, const bf16_t* H, float* U, float* DEC, bf16_t* Y,
                         const float* __restrict__ w_up, const float* __restrict__ b_up, const float* __restrict__ norm_g, unsigned char* lds) {
    float* BC = (float*)lds;
    float* LR = BC + 64 * 65;
    float* TOT = LR + 1024;
    float* OF = TOT + 512;
    bf16_t* M0 = (bf16_t*)(OF + 64 * 65);
    bf16_t* M1 = M0 + 64 * LDP; bf16_t* M2 = M1 + 64 * LDP; bf16_t* M3 = M2 + 64 * LDP; bf16_t* M4 = M3 + 64 * LDP; bf16_t* M5 = M4 + 64 * LDP;
    const int tid = ltid(), lane = tid & 63, wave = tid >> 6;
    const size_t tok0 = (size_t)b * SEQ + (size_t)n * 64;
    const size_t cidx = ((size_t)b * NCH + n) * 4 + h;
    for (int i = tid; i < 1024; i += 512) LR[i] = bf2f(H[(tok0 + (i >> 4)) * DINP + 3072 + (i & 15)]);
    __syncthreads();
    { const int d = lane, tg = wave; float wu[16];
#pragma unroll
      for (int r = 0; r < 16; ++r) wu[r] = w_up[r * 256 + h * 64 + d];
      const float bu = b_up[h * 64 + d]; float loc[8]; float run = 0.f;
#pragma unroll
      for (int i = 0; i < 8; ++i) { const int t = tg * 8 + i; float z = bu;
#pragma unroll
          for (int r = 0; r < 16; ++r) z += LR[t * 16 + r] * wu[r];
          const float ls = fminf(z, 0.f) - log1pf(expf(-fabsf(z)));
          run += ls * (1.0f / 16.0f); loc[i] = run; }
      TOT[tg * 64 + d] = run;
      __syncthreads();
      float off = 0.f;
      for (int g2 = 0; g2 < tg; ++g2) off += TOT[g2 * 64 + d];
#pragma unroll
      for (int i = 0; i < 8; ++i) BC[(tg * 8 + i) * 65 + d] = loc[i] + off; }
    __syncthreads();
    const int jr = lane, ds8 = wave * 8;
    const int rr = tid >> 3, cs8 = (tid & 7) * 8;
    if (mode == 0) {
        bf16_t* KdT = M0; bf16_t* VT = M1;
        { const u32x4 kw = *(const u32x4*)(H + (tok0 + jr) * DINP + 256 + h * 64 + ds8);
          const u32x4 vw = *(const u32x4*)(H + (tok0 + jr) * DINP + 512 + h * 64 + ds8);
          const unsigned kk[4] = {kw.x, kw.y, kw.z, kw.w}, vv[4] = {vw.x, vw.y, vw.z, vw.w};
#pragma unroll
          for (int e = 0; e < 8; ++e) { const int d = ds8 + e; const unsigned w = kk[e >> 1], x = vv[e >> 1];
              const float kf = (e & 1) ? bfhi(w) : bflo(w);
              KdT[d * LDP + jr] = f2bf(kf * __expf(BC[63 * 65 + d] - BC[jr * 65 + d]));
              VT[d * LDP + jr] = (bf16_t)((e & 1) ? (x >> 16) : (x & 0xFFFFu)); } }
        __syncthreads();
        { const int mt = wave >> 1;
#pragma unroll
          for (int q = 0; q < 2; ++q) { const int nt = (wave & 1) * 2 + q; f32x4 acc = {0.f, 0.f, 0.f, 0.f};
              acc = mma16(VT, mt * 16, KdT, nt * 16, 2, acc, lane);
#pragma unroll
              for (int i = 0; i < 4; ++i) U[cidx * 4096 + (size_t)(mt * 16 + (lane >> 4) * 4 + i) * 64 + nt * 16 + (lane & 15)] = acc[i]; } }
        if (tid < 64) DEC[cidx * 64 + tid] = __expf(BC[63 * 65 + tid]);
        __syncthreads();
        return;
    }
    bf16_t* Qe = M0; bf16_t* Ke = M1; bf16_t* VT = M2; bf16_t* Qb = M3; bf16_t* ST = M4; bf16_t* AT = M5;
    {
      const u32x4 qw = *(const u32x4*)(H + (tok0 + rr) * DINP + 0 + h * 64 + cs8);
      const u32x4 kw = *(const u32x4*)(H + (tok0 + rr) * DINP + 256 + h * 64 + cs8);
      const unsigned qq[4] = {qw.x, qw.y, qw.z, qw.w}, kk[4] = {kw.x, kw.y, kw.z, kw.w};
      float qe[8], qb[8], ke[8];
#pragma unroll
      for (int e = 0; e < 8; ++e) { const int d = cs8 + e; const float bc = BC[rr * 65 + d], rf = BC[32 * 65 + d];
          const float qf = ((e & 1) ? bfhi(qq[e >> 1]) : bflo(qq[e >> 1])) * 0.125f, kf = (e & 1) ? bfhi(kk[e >> 1]) : bflo(kk[e >> 1]);
          qe[e] = qf * __expf(bc - rf); qb[e] = qf * __expf(bc); ke[e] = kf * __expf(rf - bc); }
      u32x4 o; o.x = pack2(qe[0], qe[1]); o.y = pack2(qe[2], qe[3]); o.z = pack2(qe[4], qe[5]); o.w = pack2(qe[6], qe[7]); *(u32x4*)(Qe + rr * LDP + cs8) = o;
      o.x = pack2(qb[0], qb[1]); o.y = pack2(qb[2], qb[3]); o.z = pack2(qb[4], qb[5]); o.w = pack2(qb[6], qb[7]); *(u32x4*)(Qb + rr * LDP + cs8) = o;
      o.x = pack2(ke[0], ke[1]); o.y = pack2(ke[2], ke[3]); o.z = pack2(ke[4], ke[5]); o.w = pack2(ke[6], ke[7]); *(u32x4*)(Ke + rr * LDP + cs8) = o;
      const f32x4 s0 = *(const f32x4*)(U + cidx * 4096 + (size_t)rr * 64 + cs8), s1 = *(const f32x4*)(U + cidx * 4096 + (size_t)rr * 64 + cs8 + 4);
      o.x = pack2(s0[0], s0[1]); o.y = pack2(s0[2], s0[3]); o.z = pack2(s1[0], s1[1]); o.w = pack2(s1[2], s1[3]); *(u32x4*)(ST + rr * LDP + cs8) = o;
      const u32x4 vw = *(const u32x4*)(H + (tok0 + jr) * DINP + 512 + h * 64 + ds8);
      const unsigned vv[4] = {vw.x, vw.y, vw.z, vw.w};
#pragma unroll
      for (int e = 0; e < 8; ++e) { const unsigned x = vv[e >> 1]; VT[(ds8 + e) * LDP + jr] = (bf16_t)((e & 1) ? (x >> 16) : (x & 0xFFFFu)); } }
    __syncthreads();
    const int mt = wave >> 1, g4 = lane >> 4, r16 = lane & 15;
#pragma unroll
    for (int q = 0; q < 2; ++q) { const int nt = (wave & 1) * 2 + q; f32x4 acc = {0.f, 0.f, 0.f, 0.f};
        acc = mma16(Qe, mt * 16, Ke, nt * 16, 2, acc, lane);
#pragma unroll
        for (int i = 0; i < 4; ++i) { const int ii = mt * 16 + g4 * 4 + i, jj = nt * 16 + r16; AT[ii * LDP + jj] = f2bf(jj <= ii ? acc[i] : 0.f); } }
    __syncthreads();
#pragma unroll
    for (int q = 0; q < 2; ++q) { const int nt = (wave & 1) * 2 + q; f32x4 acc = {0.f, 0.f, 0.f, 0.f};
        acc = mma16(AT, mt * 16, VT, nt * 16, 2, acc, lane);
        acc = mma16(Qb, mt * 16, ST, nt * 16, 2, acc, lane);
#pragma unroll
        for (int i = 0; i < 4; ++i) OF[(mt * 16 + g4 * 4 + i) * 65 + nt * 16 + r16] = acc[i]; }
    __syncthreads();
    { float o[8]; float ss = 0.f;
#pragma unroll
      for (int e = 0; e < 8; ++e) { o[e] = OF[rr * 65 + cs8 + e]; ss += o[e] * o[e]; }
      ss += __shfl_xor(ss, 1, 64); ss += __shfl_xor(ss, 2, 64); ss += __shfl_xor(ss, 4, 64);
      const float rs = 1.0f / sqrtf(ss * (1.0f / 64.0f) + 1e-6f);
      const u32x4 gw = *(const u32x4*)(H + (tok0 + rr) * DINP + 768 + h * 64 + cs8);
      const unsigned gg[4] = {gw.x, gw.y, gw.z, gw.w};
#pragma unroll
      for (int e = 0; e < 8; ++e) { const float gf = (e & 1) ? bfhi(gg[e >> 1]) : bflo(gg[e >> 1]); o[e] = o[e] * rs * norm_g[cs8 + e] * siluf_(gf); }
      u32x4 w; w.x = pack2(o[0], o[1]); w.y = pack2(o[2], o[3]); w.z = pack2(o[4], o[5]); w.w = pack2(o[6], o[7]);
      *(u32x4*)(Y + (tok0 + rr) * DM + h * 64 + cs8) = w; }
    __syncthreads();
}
__device__ __forceinline__ void scan_phase(float* U, const float* DEC, const float* LA, const float* LH, float* LHIN) {
    const int gt = lbid() * 512 + ltid();
    if (gt < 65536) {
        const int bh = gt >> 12, vd = gt & 4095, b = bh >> 2, h = bh & 3, d = vd & 63;
        float st = 0.f;
        const size_t c0 = ((size_t)b * NCH) * 4 + h;
        float un = U[c0 * 4096 + vd], dn = DEC[c0 * 64 + d];
        for (int n = 0; n < NCH; ++n) {
            const size_t c = c0 + (size_t)n * 4; const float u = un, dc = dn;
            if (n + 1 < NCH) { un = U[(c + 4) * 4096 + vd]; dn = DEC[(c + 4) * 64 + d]; }
            U[c * 4096 + vd] = st; st = dc * st + u; }
    } else if (gt < 65536 + 1024) {
        const int e = gt - 65536, b = e >> 8, c = e & 255; float st = 0.f;
        for (int n = 0; n < NCH; ++n) { const size_t idx = ((size_t)b * NCH + n) * 256 + c; const float a = LA[idx], hh = LH[idx]; LHIN[idx] = st; st = a * st + hh; }
    }
}

__device__ __forceinline__ void lru_item(int mode, int b, int n, const bf16_t* H, float* LA, float* LH, const float* LHIN, bf16_t* Y,
                         const float* __restrict__ conv_w, const float* __restrict__ conv_b, const float* __restrict__ w_a, const float* __restrict__ b_a,
                         const float* __restrict__ w_i, const float* __restrict__ b_i, const float* __restrict__ lam, unsigned char* lds) {
    float* XC = (float*)lds;
    float* EXA = XC + 64 * 256; float* EXH = EXA + 256;
    const int tid = ltid(), c = tid & 255, th = tid >> 8, g = c >> 6, d = c & 63;
    const size_t tok0 = (size_t)b * SEQ + (size_t)n * 64;
    { const float w0 = conv_w[c], w1 = conv_w[256 + c], w2 = conv_w[512 + c], w3 = conv_w[768 + c], cb = conv_b[c];
      const int tb = th * 32;
      float xm3 = 0.f, xm2 = 0.f, xm1 = 0.f;
      if (n > 0 || tb > 0) { xm3 = bf2f(H[(tok0 + tb - 3) * DINP + 2560 + c]); xm2 = bf2f(H[(tok0 + tb - 2) * DINP + 2560 + c]); xm1 = bf2f(H[(tok0 + tb - 1) * DINP + 2560 + c]); }
#pragma unroll 8
      for (int tt = 0; tt < 32; ++tt) { const float x0 = bf2f(H[(tok0 + tb + tt) * DINP + 2560 + c]);
          XC[(tb + tt) * 256 + c] = cb + w0 * xm3 + w1 * xm2 + w2 * xm1 + w3 * x0; xm3 = xm2; xm2 = xm1; xm1 = x0; } }
    __syncthreads();
    float ra[32], ia[32];
    { const float ba = b_a[c], bi = b_i[c];
#pragma unroll
      for (int tt = 0; tt < 32; ++tt) { ra[tt] = ba; ia[tt] = bi; } }
    for (int c4 = 0; c4 < 16; ++c4) {
        const float* wap = w_a + ((size_t)g * 64 + c4 * 4) * 64 + d; const float* wip = w_i + ((size_t)g * 64 + c4 * 4) * 64 + d;
        const float a0 = wap[0], a1 = wap[64], a2 = wap[128], a3 = wap[192], i0 = wip[0], i1 = wip[64], i2 = wip[128], i3 = wip[192];
#pragma unroll
        for (int tt = 0; tt < 32; ++tt) { const f32x4 x = *(const f32x4*)(XC + (th * 32 + tt) * 256 + g * 64 + c4 * 4);
            ra[tt] += x[0] * a0 + x[1] * a1 + x[2] * a2 + x[3] * a3; ia[tt] += x[0] * i0 + x[1] * i1 + x[2] * i2 + x[3] * i3; } }
    { const float sp = log1pf(expf(-lam[c])); float hl = 0.f, pr = 1.f;
#pragma unroll
      for (int tt = 0; tt < 32; ++tt) { const float r = sigmoidf_(ra[tt]), ig = sigmoidf_(ia[tt]); const float la = -8.0f * r * sp;
          const float a = expf(la); const float mult = sqrtf(-expm1f(2.0f * la)); const float u = mult * ig * XC[(th * 32 + tt) * 256 + c];
          hl = a * hl + u; pr = pr * a; ra[tt] = hl; ia[tt] = pr; } }
    if (th == 0) { EXA[c] = ia[31]; EXH[c] = ra[31]; }
    __syncthreads();
    const size_t aidx = ((size_t)b * NCH + n) * 256 + c;
    if (mode == 0) {
        if (th == 1) { LA[aidx] = EXA[c] * ia[31]; LH[aidx] = ia[31] * EXH[c] + ra[31]; }
    } else {
        const float hin = LHIN[aidx]; const float s = (th == 0) ? hin : EXA[c] * hin + EXH[c];
#pragma unroll
        for (int tt = 0; tt < 32; ++tt) { const size_t tok = tok0 + th * 32 + tt; const float hf = ra[tt] + ia[tt] * s;
            const float gt = bf2f(H[tok * DINP + 2816 + c]); Y[tok * DM + 768 + c] = f2bf(hf * gelu_tanh(gt)); }
    }
    __syncthreads();
}

__device__ __forceinline__ void attn_item(int b, int n, const bf16_t* H, const bf16_t* vT, bf16_t* Y, const float* __restrict__ rel_bias, unsigned char* lds) {
    const int tid = ltid(), lane = tid & 63, h = tid >> 6, r16 = lane & 15, g4 = lane >> 4;
    float* BT = (float*)lds + h * 520;
    bf16_t* PW = (bf16_t*)(lds + 8 * 520 * 4) + h * (32 * LDP);
    for (int i = lane; i < 513; i += 64) BT[i] = rel_bias[h * 513 + i];
    asm volatile("s_waitcnt lgkmcnt(0)" ::: "memory"); __builtin_amdgcn_wave_barrier();
    const size_t tok0 = (size_t)b * SEQ + (size_t)n * 64;
    const int kb0 = (n >= 8) ? 0 : 8 - n;
    for (int qh = 0; qh < 2; ++qh) {
        bf16x8 Qa[2][2];
#pragma unroll
        for (int mt = 0; mt < 2; ++mt)
#pragma unroll
            for (int ks = 0; ks < 2; ++ks) Qa[mt][ks] = *(const bf16x8*)(H + (tok0 + qh * 32 + mt * 16 + r16) * DINP + 1024 + h * 64 + ks * 32 + g4 * 8);
        f32x4 O[2][4]; float mrow[2][4], lrow[2][4];
#pragma unroll
        for (int mt = 0; mt < 2; ++mt) {
#pragma unroll
            for (int dt = 0; dt < 4; ++dt) O[mt][dt] = (f32x4){0.f, 0.f, 0.f, 0.f};
#pragma unroll
            for (int i = 0; i < 4; ++i) { mrow[mt][i] = -1e30f; lrow[mt][i] = 0.f; } }
        for (int kb = kb0; kb < 9; ++kb) {
            const size_t ktok0 = (size_t)b * SEQ + (size_t)(n - 8 + kb) * 64;
            bf16x8 Kb[4][2], Vb[4][2];
#pragma unroll
            for (int nt = 0; nt < 4; ++nt)
#pragma unroll
                for (int ks = 0; ks < 2; ++ks) Kb[nt][ks] = *(const bf16x8*)(H + (ktok0 + nt * 16 + r16) * DINP + 1536 + h * 64 + ks * 32 + g4 * 8);
#pragma unroll
            for (int dt = 0; dt < 4; ++dt)
#pragma unroll
                for (int ks = 0; ks < 2; ++ks) Vb[dt][ks] = *(const bf16x8*)(vT + ((size_t)b * 512 + h * 64 + dt * 16 + r16) * SEQ + (size_t)(n - 8 + kb) * 64 + ks * 32 + g4 * 8);
            f32x4 S[2][4];
#pragma unroll
            for (int mt = 0; mt < 2; ++mt)
#pragma unroll
                for (int nt = 0; nt < 4; ++nt) { f32x4 a = {0.f, 0.f, 0.f, 0.f};
                    a = __builtin_amdgcn_mfma_f32_16x16x32_bf16(Qa[mt][0], Kb[nt][0], a, 0, 0, 0);
                    a = __builtin_amdgcn_mfma_f32_16x16x32_bf16(Qa[mt][1], Kb[nt][1], a, 0, 0, 0); S[mt][nt] = a; }
            const int relbase = (8 - kb) * 64;
#pragma unroll
            for (int mt = 0; mt < 2; ++mt)
#pragma unroll
                for (int i = 0; i < 4; ++i) {
                    const int qi = qh * 32 + mt * 16 + g4 * 4 + i;
                    float mx = -1e30f;
#pragma unroll
                    for (int nt = 0; nt < 4; ++nt) { int rel = qi - (nt * 16 + r16) + relbase; rel = rel > 256 ? 256 : rel;
                        const float s = S[mt][nt][i] * 0.125f + BT[rel + 256]; S[mt][nt][i] = s; mx = fmaxf(mx, s); }
                    mx = fmaxf(mx, __shfl_xor(mx, 1, 64)); mx = fmaxf(mx, __shfl_xor(mx, 2, 64)); mx = fmaxf(mx, __shfl_xor(mx, 4, 64)); mx = fmaxf(mx, __shfl_xor(mx, 8, 64));
                    const float mnew = fmaxf(mrow[mt][i], mx), alpha = __expf(mrow[mt][i] - mnew);
                    float ps = 0.f;
#pragma unroll
                    for (int nt = 0; nt < 4; ++nt) { const float pv = __expf(S[mt][nt][i] - mnew); ps += pv; PW[(mt * 16 + g4 * 4 + i) * LDP + nt * 16 + r16] = f2bf(pv); }
                    lrow[mt][i] = lrow[mt][i] * alpha + ps; mrow[mt][i] = mnew;
#pragma unroll
                    for (int dt = 0; dt < 4; ++dt) O[mt][dt][i] *= alpha;
                }
            asm volatile("s_waitcnt lgkmcnt(0)" ::: "memory"); __builtin_amdgcn_wave_barrier();
#pragma unroll
            for (int mt = 0; mt < 2; ++mt) {
                const bf16x8 p0 = *(const bf16x8*)(PW + (mt * 16 + r16) * LDP + g4 * 8), p1 = *(const bf16x8*)(PW + (mt * 16 + r16) * LDP + 32 + g4 * 8);
#pragma unroll
                for (int dt = 0; dt < 4; ++dt) { O[mt][dt] = __builtin_amdgcn_mfma_f32_16x16x32_bf16(p0, Vb[dt][0], O[mt][dt], 0, 0, 0);
                    O[mt][dt] = __builtin_amdgcn_mfma_f32_16x16x32_bf16(p1, Vb[dt][1], O[mt][dt], 0, 0, 0); } }
            asm volatile("s_waitcnt lgkmcnt(0)" ::: "memory"); __builtin_amdgcn_wave_barrier();
        }
#pragma unroll
        for (int mt = 0; mt < 2; ++mt)
#pragma unroll
            for (int i = 0; i < 4; ++i) { float l = lrow[mt][i];
                l += __shfl_xor(l, 1, 64); l += __shfl_xor(l, 2, 64); l += __shfl_xor(l, 4, 64); l += __shfl_xor(l, 8, 64);
                const float inv = 1.0f / l; const size_t tok = tok0 + qh * 32 + mt * 16 + g4 * 4 + i;
#pragma unroll
                for (int dt = 0; dt < 4; ++dt) Y[tok * DM + 256 + h * 64 + dt * 16 + r16] = f2bf(O[mt][dt][i] * inv); }
    }
}

struct Ptrs { unsigned char* ws; bf16_t* XB; bf16_t* PB; bf16_t* R1; float* X1; bf16_t* VT; float* U; float* DEC; float* LA; float* LH; float* LHIN; };
__device__ __forceinline__ Ptrs mkptrs(const Params& p) { Ptrs q; unsigned char* ws = p.ws; q.ws = ws;
    q.XB = (bf16_t*)(ws + WS_XB); q.PB = (bf16_t*)(ws + WS_PB); q.R1 = (bf16_t*)(ws + WS_R1); q.X1 = (float*)(ws + WS_X1); q.VT = (bf16_t*)(ws + WS_X1 + X1_VT); q.U = (float*)(ws + WS_X1 + X1_U);
    q.DEC = (float*)(ws + WS_SM); q.LA = q.DEC + 131072; q.LH = q.LA + 131072; q.LHIN = q.LH + 131072; return q; }

__global__ void __launch_bounds__(512, 2) fwd_megakernel(Params p_unused) {
    extern __shared__ __attribute__((aligned(16))) unsigned char lds[];
    cg::grid_group grid = cg::this_grid();
    { const Params p = fresh_params(); prologue_phase(p, lds); }
    grid.sync();
#pragma unroll 1
    for (int l = 0; l < 2; ++l) {
        { const Params p = fresh_params(); const Ptrs q = mkptrs(p);
          EpiStoreBf16 E; E.O = q.R1; E.ldc = DINP; run_gemm(lds, q.XB, (const bf16_t*)(q.ws + WS_WIN + l * SZ_WIN), DINP, DM, E); }
        grid.sync();
        { const Params p = fresh_params(); const Ptrs q = mkptrs(p); const int G = gridDim.x;
          for (int it = lbid(); it < 3072; it += G) {
            if (it < 512) lru_item(0, it >> 7, it & 127, q.R1, q.LA, q.LH, q.LHIN, q.XB, p.in[7] + l * 1024, p.in[8] + l * 256, p.in[9] + l * 16384, p.in[10] + l * 256, p.in[11] + l * 16384, p.in[12] + l * 256, p.in[13] + l * 256, lds);
            else if (it < 2560) { const int e = it - 512; gla_item(0, e >> 9, (e >> 2) & 127, e & 3, q.R1, q.U, q.DEC, q.XB, p.in[3] + l * 4096, p.in[4] + l * 256, p.in[5] + l * 64, lds); }
            else { const int e = it - 2560; vtrans_item(e >> 7, e & 127, q.R1, q.VT, lds); }
          } }
        grid.sync();
        { const Params p = fresh_params(); const Ptrs q = mkptrs(p); scan_phase(q.U, q.DEC, q.LA, q.LH, q.LHIN); }
        grid.sync();
        { const Params p = fresh_params(); const Ptrs q = mkptrs(p); const int G = gridDim.x;
          for (int it = lbid(); it < 3072; it += G) {
            if (it < 512) { __syncthreads(); attn_item(it >> 7, it & 127, q.R1, q.VT, q.XB, p.in[6], lds); __syncthreads(); }
            else if (it < 1024) { const int e = it - 512; lru_item(1, e >> 7, e & 127, q.R1, q.LA, q.LH, q.LHIN, q.XB, p.in[7] + l * 1024, p.in[8] + l * 256, p.in[9] + l * 16384, p.in[10] + l * 256, p.in[11] + l * 16384, p.in[12] + l * 256, p.in[13] + l * 256, lds); }
            else { const int e = it - 1024; gla_item(1, e >> 9, (e >> 2) & 127, e & 3, q.R1, q.U, q.DEC, q.XB, p.in[3] + l * 4096, p.in[4] + l * 256, p.in[5] + l * 64, lds); }
          } }
        grid.sync();
        { const Params p = fresh_params(); const Ptrs q = mkptrs(p);
          EpiF32<0> E; E.C = q.X1; E.R = (l == 0) ? p.in[0] : p.out; E.P = nullptr; run_gemm(lds, q.XB, (const bf16_t*)(q.ws + WS_WOUT + l * SZ_WOUT), DM, DM, E); }
        grid.sync();
        { const Params p = fresh_params(); const Ptrs q = mkptrs(p);
          ln_phase(q.X1, q.X1, q.XB, p.in[15] + l * DM, p.in[16] + l * DM);
          cvt_rows_bf16(p.in[1] + (size_t)l * T_TOK * PLE, q.PB, (size_t)T_TOK * PLE / 8); }
        grid.sync();
        { const Params p = fresh_params(); const Ptrs q = mkptrs(p);
          EpiSwiGLU E; E.O = q.R1; run_gemm(lds, q.XB, (const bf16_t*)(q.ws + WS_WGU + l * SZ_WGU), 2 * DFF, DM, E); }
        { const Params p = fresh_params(); const Ptrs q = mkptrs(p);
          EpiF32<1> E; E.C = p.out; E.R = nullptr; E.P = nullptr; run_gemm(lds, q.XB, (const bf16_t*)(q.ws + WS_WPG + l * SZ_WPG), DM, DM, E); }
        { const Params p = fresh_params(); const Ptrs q = mkptrs(p);
          EpiF32<2> E; E.C = p.out; E.R = nullptr; E.P = nullptr; run_gemm(lds, q.PB, (const bf16_t*)(q.ws + WS_WPP + l * SZ_WPP), DM, PLE, E); }
        grid.sync();
        { const Params p = fresh_params(); const Ptrs q = mkptrs(p);
          EpiF32<3> E; E.C = q.X1; E.R = q.X1; E.P = p.out; run_gemm(lds, q.R1, (const bf16_t*)(q.ws + WS_WDN + l * SZ_WDN), DM, DFF, E); }
        grid.sync();
        { const Params p = fresh_params(); const Ptrs q = mkptrs(p);
          ln_phase(q.X1, p.out, (l == 0) ? q.XB : nullptr, p.in[22] + l * DM, p.in[23] + l * DM); }
        grid.sync();
    }
}

extern "C" void kernel_launch(void* const* d_in, const int* in_sizes, int n_in, void* d_out, int out_size, void* d_ws, size_t ws_size, hipStream_t stream) {
    constexpr int kLds = 131072;
    static int grid_blocks = 0;
    if (grid_blocks == 0) {
        if (n_in != 24 || out_size != T_TOK * DM || ws_size < WS_END) { fprintf(stderr, "kernel_launch: unexpected shapes (n_in %d out %d ws %zu need %zu)\n", n_in, out_size, ws_size, (size_t)WS_END); grid_blocks = -1; return; }
        int dev = 0, cus = 0, per_cu = 0;
        hipGetDevice(&dev);
        hipDeviceGetAttribute(&cus, hipDeviceAttributeMultiprocessorCount, dev);
        if (hipFuncSetAttribute((const void*)fwd_megakernel, hipFuncAttributeMaxDynamicSharedMemorySize, kLds) != hipSuccess) { fprintf(stderr, "kernel_launch: hipFuncSetAttribute failed\n"); grid_blocks = -1; return; }
        if (hipOccupancyMaxActiveBlocksPerMultiprocessor(&per_cu, (const void*)fwd_megakernel, 512, kLds) != hipSuccess || per_cu < 1) { fprintf(stderr, "kernel_launch: occupancy query says %d\n", per_cu); per_cu = 1; (void)hipGetLastError(); }
        if (per_cu > 1) per_cu = 1;
        grid_blocks = cus * per_cu;
    }
    if (grid_blocks < 0) return;
    Params p{};
    for (int i = 0; i < 24; ++i) p.in[i] = (const float*)d_in[i];
    p.out = (float*)d_out; p.ws = (unsigned char*)d_ws;
    void* args[] = {&p};
    hipError_t e = hipLaunchCooperativeKernel((const void*)fwd_megakernel, dim3(grid_blocks), dim3(512), args, kLds, stream);
    if (e != hipSuccess) fprintf(stderr, "cooperative launch failed: %s (grid %d)\n", hipGetErrorString(e), grid_blocks);
}
```

```cpp
#include <hip/hip_runtime.h>
#include <hip/hip_cooperative_groups.h>
#include <cstdio>
namespace cg = cooperative_groups;

constexpr int T_TOK = 32768, SEQ = 8192, NB = 4, NCH = 128, DM = 1024, DINP = 3328, DFF = 2816, PLE = 256;
constexpr float DN_ALPHA = 1.41421356237309515f;
constexpr size_t SZ_WIN = (size_t)DINP * DM * 2, SZ_WOUT = (size_t)DM * DM * 2, SZ_WGU = (size_t)(2 * DFF + DM) * DM * 2, SZ_WDN = (size_t)DM * DFF * 2, SZ_WPG = (size_t)DM * DM * 2, SZ_WPP = (size_t)DM * PLE * 2;
constexpr size_t WS_WIN = 0;
constexpr size_t WS_WOUT = WS_WIN + 2 * SZ_WIN;
constexpr size_t WS_WGU = WS_WOUT + 2 * SZ_WOUT;
constexpr size_t WS_WDN = WS_WGU + 2 * SZ_WGU;
constexpr size_t WS_WPP = WS_WDN + 2 * SZ_WDN;
constexpr size_t WS_XB = WS_WPP + 2 * SZ_WPP;
constexpr size_t WS_PB = WS_XB + (size_t)T_TOK * DM * 2;
constexpr size_t WS_R1 = WS_PB + (size_t)T_TOK * PLE * 2;
constexpr size_t WS_X1 = WS_R1 + (size_t)T_TOK * DINP * 2;
constexpr size_t WS_SM = WS_X1 + (size_t)T_TOK * DM * 4;
constexpr size_t WS_WLRU = WS_SM + 4 * 524288;
constexpr size_t WS_BAR = WS_WLRU + 131072;
constexpr size_t WS_ST = WS_BAR + 16384;
constexpr size_t WS_LRB = WS_ST + (size_t)4 * T_TOK * 4;
constexpr size_t WS_END = WS_LRB + (size_t)T_TOK * 16 * 4;
constexpr size_t X1_VT = 0, X1_U = (size_t)T_TOK * 512 * 2, X1_SP = X1_U + (size_t)NB * NCH * 4 * 4096 * 4, X1_KP = X1_SP + (size_t)NB * NCH * 4 * 4096 * 4;

typedef unsigned short bf16_t;
typedef unsigned u32x4 __attribute__((ext_vector_type(4)));
typedef unsigned u32x2 __attribute__((ext_vector_type(2)));

__device__ __forceinline__ bf16_t f2bf(float f) { unsigned u = __float_as_uint(f); u += 0x7FFFu + ((u >> 16) & 1u); return (bf16_t)(u >> 16); }
__device__ __forceinline__ float bf2f(bf16_t b) { return __uint_as_float(((unsigned)b) << 16); }
__device__ __forceinline__ unsigned pack2(float lo, float hi) { return (unsigned)f2bf(lo) | ((unsigned)f2bf(hi) << 16); }
__device__ __forceinline__ float bflo(unsigned w) { return __uint_as_float(w << 16); }
__device__ __forceinline__ float bfhi(unsigned w) { return __uint_as_float(w & 0xFFFF0000u); }
__device__ __forceinline__ float sigmoidf_(float x) { return __builtin_amdgcn_rcpf(1.0f + __builtin_amdgcn_exp2f(-1.4426950408889634f * x)); }
__device__ __forceinline__ float siluf_(float x) { return x * __builtin_amdgcn_rcpf(1.0f + __builtin_amdgcn_exp2f(-1.4426950408889634f * x)); }
__device__ __forceinline__ float gelu_tanh(float x) { const float u = 0.7978845608028654f * (x + 0.044715f * x * x * x); const float e = __builtin_amdgcn_exp2f(2.8853900817779268f * u); const float th = 1.0f - 2.0f * __builtin_amdgcn_rcpf(e + 1.0f); return 0.5f * x * (1.0f + th); }

struct Params { const float* in[24]; float* out; unsigned char* ws; };


__device__ __forceinline__ int ltid() { int t = threadIdx.x; asm volatile("" : "+v"(t)); return t; }
__device__ __forceinline__ int lbid() { int t = blockIdx.x; asm volatile("" : "+s"(t)); return t; }
__device__ __forceinline__ Params fresh_params() {
    const __attribute__((address_space(4))) Params* kp = (const __attribute__((address_space(4))) Params*)__builtin_amdgcn_kernarg_segment_ptr();
    asm volatile("" : "+s"(kp)); Params r;
#pragma unroll
    for (int i = 0; i < 24; ++i) r.in[i] = kp->in[i];
    r.out = kp->out; r.ws = kp->ws; return r; }
__device__ __forceinline__ float neg_expm1(float t) { return (t > -0.5f) ? -t * (1.0f + t * (0.5f + t * (0.16666667f + t * (0.041666668f + t * (0.0083333338f + t * 0.0013888889f))))) : 1.0f - __expf(t); }
constexpr int LDS_BAR_OFF = 134912;
constexpr int LDS_BT_OFF = LDS_BAR_OFF + 256;
namespace pg8 {
#define PG8_LAS __attribute__((address_space(3)))
typedef unsigned short bf16_t;
typedef short bf16x8 __attribute__((ext_vector_type(8)));
typedef float f32x4 __attribute__((ext_vector_type(4)));
typedef unsigned u32x4 __attribute__((ext_vector_type(4)));
constexpr int BM = 256, BK = 64, HALF = 128, HTB = HALF * BK * 2  , STAGE_BYTES = 8 * HTB, NXCD = 8, WGM = 8;

__host__ __device__ __forceinline__ int lds_byte(int r, int c) { const int st = (r >> 4) * 2 + (c >> 5), rr = r & 15, cc = c & 31, ob = rr * 64 + cc * 2; return st * 1024 + (ob ^ (((ob >> 9) & 1) << 5)); }
__host__ __device__ __forceinline__ void stage_rc(int b, int& R, int& C) { const int st = b / 1024, sb = b % 1024, swz = sb ^ (((sb >> 9) & 1) << 5); R = (st >> 1) * 16 + swz / 64; C = (st & 1) * 32 + (swz % 64) / 2; }
__host__ __device__ __forceinline__ int perm32(int rho) { const int n = rho >> 4, i = rho & 15; return 8 * (i >> 2) + 4 * n + (i & 3); }

struct Unit { int pm, pn; };
struct Gemm { const bf16_t* A; const bf16_t* Bt; int M, N, K; };

struct StaticOrder {
    int nM, nN, nwg, G, c;
    __host__ __device__ void init(int M, int N, int G_, int c_) { nM = M / BM; nN = N / BM; nwg = nM * nN; G = G_; c = c_; }
    __host__ __device__ bool next(int i, Unit& u) const {
        const long L = (long)i * G + c; if (L >= nwg) return false;
        int wgid = (int)L; { const int q = nwg / NXCD, r = nwg % NXCD, xcd = wgid % NXCD, off = wgid / NXCD; wgid = (xcd < r ? xcd * (q + 1) : r * (q + 1) + (xcd - r) * q) + off; }
        const int nig = WGM * nN, gid = wgid / nig, fm = gid * WGM, gsz = (nM - fm) < WGM ? (nM - fm) : WGM;
        u.pm = fm + ((wgid % nig) % gsz); u.pn = (wgid % nig) / gsz; return true;
    }
    __device__ __forceinline__ void a_ready(const Unit&) const {}
    __device__ __forceinline__ void done(const Unit&) const {}
};
__device__ __forceinline__ unsigned cvt_pk_bf16(float lo, float hi) { unsigned r; asm volatile("v_cvt_pk_bf16_f32 %0, %1, %2" : "=v"(r) : "v"(lo), "v"(hi)); return r; }
typedef float f32x2 __attribute__((ext_vector_type(2)));
template <class Epi, class Sched, bool STAMP = false>
__device__ __forceinline__ void gemm_phase(PG8_LAS unsigned char* lds, const Gemm g, const Sched& S, const Epi& E, unsigned long long* stamps) {
    const int tid = ltid(), wid = __builtin_amdgcn_readfirstlane(tid >> 6), lane = tid & 63, wr = wid >> 2, wc = wid & 3, fr = lane & 15, fq = lane >> 4;
    const int K = g.K, nt = K / BK;
    int ts_lo = 0, ts_hi = 0, nts = 0; const unsigned long long rt_entry = STAMP ? (unsigned long long)wall_clock64() : 0ull;
#define PG8_STAMP() do { if (STAMP && wid == 0 && nts < 64) { const unsigned long long _c = (unsigned long long)clock64(); \
        ts_lo = (lane == nts) ? (int)(unsigned)_c : ts_lo; ts_hi = (lane == nts) ? (int)(unsigned)(_c >> 32) : ts_hi; ++nts; } } while (0)
    PG8_STAMP();
    unsigned voffA[2], voffB[2];
#pragma unroll
    for (int i = 0; i < 2; ++i) { int R, C; stage_rc(tid * 16 + i * 8192, R, C); const int Rb = Epi::PERM ? ((R & ~31) + perm32(R & 31)) : R;
        voffA[i] = (unsigned)(R * K + C) * 2u; voffB[i] = (unsigned)(Rb * K + C) * 2u; }
    const size_t kstep = (size_t)(BK * 2);
    const size_t hstep = (size_t)HALF * K * 2;
    const size_t tstep = 2 * hstep;
    const unsigned ldsw = (unsigned)wid * 1024u;
    const int aoff = lds_byte(wr * 64 + fr, fq * 8), boff = lds_byte(wc * 32 + fr, fq * 8);
#define PG8_SA(b, h) (((b) * 2 + (h)) * HTB)
#define PG8_SB(b, h) ((4 + (b) * 2 + (h)) * HTB)
#define PG8_STAGE(bufoff, gbase, voff) do { _Pragma("unroll") for (int _i = 0; _i < 2; ++_i) \
        __builtin_amdgcn_global_load_lds((const unsigned*)((const char*)(gbase) + (voff)[_i]), (PG8_LAS unsigned*)(lds + (bufoff) + ldsw + _i * 8192), 16, 0, 0); } while (0)
#define PG8_LDA(dst, b, h) do { _Pragma("unroll") for (int m = 0; m < 4; ++m) _Pragma("unroll") for (int k = 0; k < 2; ++k) dst[m][k] = *(const PG8_LAS bf16x8*)(lds + PG8_SA(b, h) + aoff + m * 2048 + k * 1024); } while (0)
#define PG8_LDB(dst, b, h) do { _Pragma("unroll") for (int n = 0; n < 2; ++n) _Pragma("unroll") for (int k = 0; k < 2; ++k) dst[n][k] = *(const PG8_LAS bf16x8*)(lds + PG8_SB(b, h) + boff + n * 2048 + k * 1024); } while (0)
#define PG8_MMA(ai, bj, At, Bt) do { __builtin_amdgcn_s_setprio(1); _Pragma("unroll") for (int m = 0; m < 4; ++m) _Pragma("unroll") for (int n = 0; n < 2; ++n) _Pragma("unroll") for (int k = 0; k < 2; ++k) \
        acc[ai][bj][m][n] = __builtin_amdgcn_mfma_f32_16x16x32_bf16(Bt[n][k], At[m][k], acc[ai][bj][m][n], 0, 0, 0); __builtin_amdgcn_s_setprio(0); } while (0)
#define PG8_WAIT_V(n) asm volatile("s_waitcnt vmcnt(" #n ")" ::: "memory")
#define PG8_WAIT_L(n) asm volatile("s_waitcnt lgkmcnt(" #n ")" ::: "memory")
#define PG8_BAR __builtin_amdgcn_s_barrier()
#define PG8_SCHED __builtin_amdgcn_sched_barrier(0)
    Unit cur, nxt; int ui = 0;
    if (!S.next(0, cur)) return;
    f32x4 acc[2][2][4][2];
#pragma unroll
    for (int a = 0; a < 2; ++a)
#pragma unroll
        for (int b = 0; b < 2; ++b)
#pragma unroll
            for (int m = 0; m < 4; ++m)
#pragma unroll
                for (int n = 0; n < 2; ++n) acc[a][b][m][n] = (f32x4){0.f, 0.f, 0.f, 0.f};
    bf16x8 At[4][2], B0[2][2], B1[2][2];
    const char* cA = (const char*)g.A + (size_t)cur.pm * tstep; const char* cB = (const char*)g.Bt + (size_t)cur.pn * tstep;
    S.a_ready(cur);
    PG8_STAGE(PG8_SB(0, 0), cB, voffB); PG8_STAGE(PG8_SA(0, 0), cA, voffA); PG8_STAGE(PG8_SB(0, 1), cB + hstep, voffB); PG8_STAGE(PG8_SA(0, 1), cA + hstep, voffA);
    if (wr == 1) PG8_BAR;
    PG8_WAIT_V(4); PG8_BAR;
    PG8_STAGE(PG8_SB(1, 0), cB + kstep, voffB); PG8_STAGE(PG8_SA(1, 0), cA + kstep, voffA); PG8_STAGE(PG8_SB(1, 1), cB + hstep + kstep, voffB);
    PG8_WAIT_V(6); PG8_BAR;
    PG8_STAMP();
    for (;;) {
        const bool has_next = S.next(ui + 1, nxt);
        const char* nA = has_next ? (const char*)g.A + (size_t)nxt.pm * tstep : cA; const char* nB = has_next ? (const char*)g.Bt + (size_t)nxt.pn * tstep : cB;
        for (int t = 0; t < nt; t += 2) {
            const bool last = (t == nt - 2);
            const char* a1 = cA + (size_t)(t + 1) * kstep;
            const char* a2 = last ? nA : cA + (size_t)(t + 2) * kstep; const char* b2 = last ? nB : cB + (size_t)(t + 2) * kstep;
            const char* a3 = a2 + kstep; const char* b3 = b2 + kstep;
            if (last && has_next) S.a_ready(nxt);
            PG8_LDB(B0, 0, 0); PG8_SCHED; PG8_LDA(At, 0, 0); PG8_STAGE(PG8_SA(1, 1), a1 + hstep, voffA);
            PG8_WAIT_L(8); PG8_BAR; PG8_WAIT_L(0); PG8_MMA(0, 0, At, B0); PG8_BAR; PG8_SCHED;
            PG8_LDB(B1, 0, 1); PG8_STAGE(PG8_SB(0, 0), b2, voffB);
            PG8_BAR; PG8_WAIT_L(0); PG8_MMA(0, 1, At, B1); PG8_BAR;
            PG8_LDA(At, 0, 1); PG8_STAGE(PG8_SA(0, 0), a2, voffA);
            PG8_BAR; PG8_WAIT_L(0); PG8_MMA(1, 0, At, B0); PG8_BAR; PG8_SCHED;
            PG8_STAGE(PG8_SB(0, 1), b2 + hstep, voffB);
            PG8_WAIT_V(6); PG8_BAR; PG8_MMA(1, 1, At, B1); PG8_BAR;
            PG8_LDB(B0, 1, 0); PG8_SCHED; PG8_LDA(At, 1, 0); PG8_STAGE(PG8_SA(0, 1), a2 + hstep, voffA);
            PG8_WAIT_L(8); PG8_BAR; PG8_WAIT_L(0); PG8_MMA(0, 0, At, B0); PG8_BAR; PG8_SCHED;
            PG8_LDB(B1, 1, 1); PG8_STAGE(PG8_SB(1, 0), b3, voffB);
            PG8_BAR; PG8_WAIT_L(0); PG8_MMA(0, 1, At, B1); PG8_BAR;
            PG8_LDA(At, 1, 1); PG8_STAGE(PG8_SA(1, 0), a3, voffA);
            PG8_BAR; PG8_WAIT_L(0); PG8_MMA(1, 0, At, B0); PG8_BAR; PG8_SCHED;
            PG8_STAGE(PG8_SB(1, 1), b3 + hstep, voffB);
            PG8_WAIT_V(6); PG8_BAR; PG8_MMA(1, 1, At, B1); PG8_BAR;
        }
        PG8_STAMP();
        if constexpr (!Epi::AFTER_DRAIN) { E(acc, cur, wr, wc, fr, fq); S.done(cur); }
        PG8_STAMP();
        if (!has_next) break;
#pragma unroll
        for (int a = 0; a < 2; ++a)
#pragma unroll
            for (int b = 0; b < 2; ++b)
#pragma unroll
                for (int m = 0; m < 4; ++m)
#pragma unroll
                    for (int n = 0; n < 2; ++n) acc[a][b][m][n] = (f32x4){0.f, 0.f, 0.f, 0.f};
        cur = nxt; cA = nA; cB = nB; ++ui;
    }
    PG8_WAIT_V(0);
    if (wr == 0) PG8_BAR;
    PG8_BAR;
    if constexpr (Epi::AFTER_DRAIN) { E.fused(acc, cur, wr, wc, fr, fq, lds, wid, lane); S.done(cur); }
    PG8_STAMP();
    if (STAMP && wid == 0) { stamps[lane] = lane < nts ? (((unsigned long long)(unsigned)ts_hi << 32) | (unsigned)ts_lo) : 0ull;
        if (lane == 62) stamps[62] = rt_entry; if (lane == 63) stamps[63] = (unsigned long long)wall_clock64(); }
#undef PG8_STAMP
#undef PG8_SA
#undef PG8_SB
#undef PG8_STAGE
#undef PG8_LDA
#undef PG8_LDB
#undef PG8_MMA
#undef PG8_WAIT_V
#undef PG8_WAIT_L
#undef PG8_BAR
#undef PG8_SCHED
}
}
#define LAS __attribute__((address_space(3)))
#define XB_TMO      128
#define XB_XCNT(j)  (256  + 64 * (j))
#define XB_XSUB(j)  (1280 + 64 * (j))
#define XB_XGEN(j)  (2304 + 64 * (j))
#define XB_TOP      3328
#define XB_TOPGEN   3392
#define XCD_BAR_WORDS 3456
#define XB_SPIN_CAP (1u << 18)

__device__ __forceinline__ unsigned xb_ld(unsigned* p)              { return __hip_atomic_load(p, __ATOMIC_RELAXED, __HIP_MEMORY_SCOPE_AGENT); }
__device__ __forceinline__ unsigned xb_add(unsigned* p, unsigned v) { return __hip_atomic_fetch_add(p, v, __ATOMIC_RELAXED, __HIP_MEMORY_SCOPE_AGENT); }
__device__ __forceinline__ unsigned xb_xcc_id() { return (unsigned)__builtin_amdgcn_s_getreg((3 << 11) | 20) & 0xFu; }
#define XB_SPIN(cond, bar) do { unsigned _sp = 0; while (cond) { __builtin_amdgcn_s_sleep(1); \
    if ((++_sp & 255u) == 0u) { if (xb_ld(&(bar)[XB_TMO])) break; if (_sp > XB_SPIN_CAP) { atomicAdd(&(bar)[XB_TMO], 1u); break; } } } } while (0)

struct XcdBarrier {
    unsigned* bar; unsigned x;
    volatile LAS unsigned* st;
};

__device__ __forceinline__ XcdBarrier xcd_barrier_post(unsigned* bar, volatile LAS unsigned* st) {
    XcdBarrier b; b.bar = bar; b.x = xb_xcc_id(); b.st = st;
    if (threadIdx.x == 0) (void)xb_add(&bar[XB_XCNT(b.x)], 1u);
    return b;
}
__device__ __forceinline__ void xcd_barrier_complete(unsigned* bar, unsigned x, unsigned& nloc, unsigned& nx) {
    const unsigned G = gridDim.x * gridDim.y * gridDim.z;
    unsigned sum, cnt, mine, sp = 0u;
    for (;;) {
        sum = 0u; cnt = 0u; mine = 0u;
#pragma unroll
        for (unsigned j = 0; j < 16; ++j) { const unsigned c = xb_ld(&bar[XB_XCNT(j)]); sum += c; cnt += (c > 0u) ? 1u : 0u; mine = (j == x) ? c : mine; }
        if (sum == G) break;
        __builtin_amdgcn_s_sleep(1);
        if ((++sp & 255u) == 0u) { if (xb_ld(&bar[XB_TMO])) break; if (sp > XB_SPIN_CAP) { atomicAdd(&bar[XB_TMO], 1u); break; } }
    }
    nloc = mine > 0u ? mine : 1u; nx = cnt > 0u ? cnt : 1u;
}

__device__ __forceinline__ void xcd_barrier(const XcdBarrier& b) {
    asm volatile("s_waitcnt vmcnt(0)" ::: "memory");
    __syncthreads();
    if (threadIdx.x == 0) {
        unsigned* bar = b.bar;
        __builtin_amdgcn_s_waitcnt(0);
        unsigned nloc = b.st[0], nx = b.st[1];
        if (nloc == 0u) { xcd_barrier_complete(bar, b.x, nloc, nx); b.st[0] = nloc; b.st[1] = nx; }
        const unsigned old = xb_add(&bar[XB_XSUB(b.x)], 1u);
        const unsigned gen = old / nloc;
        if (old + 1u == (gen + 1u) * nloc) {
            __builtin_amdgcn_fence(__ATOMIC_RELEASE, "agent");
            asm volatile("s_waitcnt vmcnt(0)" ::: "memory");
            const unsigned og = xb_add(&bar[XB_TOP], 1u);
            const unsigned tg = og / nx;
            if (og + 1u == (tg + 1u) * nx) xb_add(&bar[XB_TOPGEN], 1u);
            else XB_SPIN(xb_ld(&bar[XB_TOPGEN]) == tg, bar);
            __builtin_amdgcn_fence(__ATOMIC_ACQUIRE, "agent");
            xb_add(&bar[XB_XGEN(b.x)], 1u);
            asm volatile("s_waitcnt vmcnt(0)" ::: "memory");
        } else {
            XB_SPIN(xb_ld(&bar[XB_XGEN(b.x)]) == gen, bar);
            __builtin_amdgcn_fence(__ATOMIC_ACQUIRE, "agent");
            asm volatile("s_waitcnt vmcnt(0)" ::: "memory");
        }
    }
    __syncthreads();
}


using pg8::bf16x8; using pg8::f32x4; using pg8::Unit;

struct EpiStoreBf16 {
    static constexpr bool PERM = true, AFTER_DRAIN = false;
    bf16_t* O; int ldc;
    __device__ __forceinline__ void operator()(const f32x4 (&acc)[2][2][4][2], const Unit& u, int wr, int wc, int fr, int fq) const {
        const int row0 = u.pm * 256 + wr * 64 + fr, col0 = u.pn * 256 + wc * 32 + 8 * fq;
#pragma unroll
        for (int ai = 0; ai < 2; ++ai)
#pragma unroll
            for (int m = 0; m < 4; ++m) { bf16_t* rowp = O + (size_t)(row0 + ai * 128 + m * 16) * ldc + col0;
#pragma unroll
                for (int bj = 0; bj < 2; ++bj) { const f32x4 v0 = acc[ai][bj][m][0], v1 = acc[ai][bj][m][1];
                    u32x4 o; o.x = pg8::cvt_pk_bf16(v0[0], v0[1]); o.y = pg8::cvt_pk_bf16(v0[2], v0[3]); o.z = pg8::cvt_pk_bf16(v1[0], v1[1]); o.w = pg8::cvt_pk_bf16(v1[2], v1[3]);
                    *(u32x4*)(rowp + bj * 128) = o; } }
    }
};
struct EpiGUPG {
    static constexpr bool PERM = true, AFTER_DRAIN = false;
    bf16_t* O; float* PL;
    __device__ __forceinline__ void operator()(const f32x4 (&acc)[2][2][4][2], const Unit& u, int wr, int wc, int fr, int fq) const {
        const int row0 = u.pm * 256 + wr * 64 + fr;
        if (u.pn < 22) {
            const int col0 = u.pn * 128 + wc * 32 + 8 * fq;
#pragma unroll
            for (int ai = 0; ai < 2; ++ai)
#pragma unroll
                for (int m = 0; m < 4; ++m) { bf16_t* rowp = O + (size_t)(row0 + ai * 128 + m * 16) * DFF + col0;
                    float h[8];
#pragma unroll
                    for (int n = 0; n < 2; ++n)
#pragma unroll
                        for (int j = 0; j < 4; j += 2) {
                            const float g1 = acc[ai][0][m][n][j], g2 = acc[ai][0][m][n][j + 1];
                            const float t1 = 1.0f + __builtin_amdgcn_exp2f(fminf(-1.4426950408889634f * g1, 60.f)), t2 = 1.0f + __builtin_amdgcn_exp2f(fminf(-1.4426950408889634f * g2, 60.f));
                            const float inv = __builtin_amdgcn_rcpf(t1 * t2);
                            h[n * 4 + j] = g1 * acc[ai][1][m][n][j] * (inv * t2); h[n * 4 + j + 1] = g2 * acc[ai][1][m][n][j + 1] * (inv * t1); }
                    u32x4 o; o.x = pg8::cvt_pk_bf16(h[0], h[1]); o.y = pg8::cvt_pk_bf16(h[2], h[3]); o.z = pg8::cvt_pk_bf16(h[4], h[5]); o.w = pg8::cvt_pk_bf16(h[6], h[7]);
                    *(u32x4*)rowp = o; }
        } else {
            const int col0 = (u.pn - 22) * 256 + wc * 32 + 8 * fq;
#pragma unroll
            for (int ai = 0; ai < 2; ++ai)
#pragma unroll
                for (int m = 0; m < 4; ++m) { float* rowp = PL + (size_t)(row0 + ai * 128 + m * 16) * DM + col0;
#pragma unroll
                    for (int bj = 0; bj < 2; ++bj)
#pragma unroll
                        for (int n = 0; n < 2; ++n) { const f32x4 a = acc[ai][bj][m][n]; f32x4 o; o[0] = sigmoidf_(a[0]); o[1] = sigmoidf_(a[1]); o[2] = sigmoidf_(a[2]); o[3] = sigmoidf_(a[3]);
                            *(f32x4*)(rowp + bj * 128 + 4 * n) = o; } }
        }
    }
};
template <int MODE> struct EpiF32 {
    static constexpr bool PERM = false, AFTER_DRAIN = false;
    float* C; const float* R; const float* P; const float* ST; const float* g; const float* b; int nostore = 0; bf16_t* PPB = nullptr;
    __device__ __forceinline__ void operator()(const f32x4 (&acc)[2][2][4][2], const Unit& u, int wr, int wc, int fr, int fq) const {
        const int row0 = u.pm * 256 + wr * 64 + fr, col0 = u.pn * 256 + wc * 32 + 4 * fq;
        f32x4 gv[2][2], bv[2][2];
        if (MODE >= 4) {
#pragma unroll
            for (int bj = 0; bj < 2; ++bj)
#pragma unroll
                for (int n = 0; n < 2; ++n) { gv[bj][n] = *(const f32x4*)(g + col0 + bj * 128 + n * 16); bv[bj][n] = *(const f32x4*)(b + col0 + bj * 128 + n * 16); } }
#pragma unroll
        for (int ai = 0; ai < 2; ++ai)
#pragma unroll
            for (int m = 0; m < 4; ++m) { const int row = row0 + ai * 128 + m * 16; const size_t rb = (size_t)row * DM + col0;
                float mean = 0.f, rstd = 0.f;
                if (MODE >= 4) { mean = ST[2 * row]; rstd = ST[2 * row + 1]; }
#pragma unroll
                for (int bj = 0; bj < 2; ++bj)
#pragma unroll
                    for (int n = 0; n < 2; ++n) { const size_t idx = rb + bj * 128 + n * 16; const f32x4 a = acc[ai][bj][m][n]; f32x4 o;
                        if (MODE == 0) { const f32x4 r = __builtin_nontemporal_load((const f32x4*)(R + idx)); o = r * DN_ALPHA + a; }
                        else if (MODE == 2) { u32x2 w; w.x = pg8::cvt_pk_bf16(a[0], a[1]); w.y = pg8::cvt_pk_bf16(a[2], a[3]); if (!nostore) *(u32x2*)(PPB + idx) = w; continue; }
                        else { const f32x4 z = *(const f32x4*)(C + idx); const f32x4 x = (z - mean) * rstd * gv[bj][n] + bv[bj][n]; o = x * DN_ALPHA + a;
                               if (MODE == 5) { const f32x4 sg = *(const f32x4*)(P + idx); const u32x2 c = *(const u32x2*)(PPB + idx);
                                   o[0] += sg[0] * bflo(c.x); o[1] += sg[1] * bfhi(c.x); o[2] += sg[2] * bflo(c.y); o[3] += sg[3] * bfhi(c.y); } }
                        if (!nostore) *(f32x4*)(C + idx) = o; } }
    }
};

template <class Epi> __device__ __forceinline__ void run_gemm(unsigned char* lds, const bf16_t* A, const bf16_t* Bt, int N, int K, const Epi& E) {
    pg8::Gemm g; g.A = A; g.Bt = Bt; g.M = T_TOK; g.N = N; g.K = K;
    pg8::StaticOrder S; S.init(T_TOK, N, (int)gridDim.x, lbid());
    pg8::gemm_phase<Epi, pg8::StaticOrder, false>((LAS unsigned char*)lds, g, S, E, nullptr);
    __syncthreads();
}

__device__ __forceinline__ int map_col(int n, int mode) {
    if (mode == 1) return n < 1024 ? n : (n < 1040 ? n - 1024 + 3072 : n - 16);
    if (mode == 2) return (n >> 7) * 256 + (n & 127);
    if (mode == 3) return (n >> 7) * 256 + 128 + (n & 127);
    return n;
}
__device__ __forceinline__ void transpose_job(const float* __restrict__ src, bf16_t* __restrict__ dst, int K, int N, int mode, float* tile, int& base) {
    const int tid = ltid(), G = gridDim.x;
    const int ntn = (N + 255) >> 8, ntile = (K >> 6) * ntn;
    int t0 = ((int)blockIdx.x - (base % G) + G) % G;
    for (int t = t0; t < ntile; t += G) {
        const int k0 = (t / ntn) << 6, n0 = (t % ntn) << 8;
        f32x4 v[8];
#pragma unroll
        for (int i = 0; i < 8; ++i) { const int kk = (tid >> 6) + 8 * i, nn = (tid & 63) * 4, n = n0 + nn;
            v[i] = (n < N) ? __builtin_nontemporal_load((const f32x4*)(src + (size_t)(k0 + kk) * N + n)) : (f32x4){0.f, 0.f, 0.f, 0.f}; }
#pragma unroll
        for (int i = 0; i < 8; ++i) { const int kk = (tid >> 6) + 8 * i, nn = (tid & 63) * 4;
            tile[kk * 257 + nn] = v[i][0]; tile[kk * 257 + nn + 1] = v[i][1]; tile[kk * 257 + nn + 2] = v[i][2]; tile[kk * 257 + nn + 3] = v[i][3]; }
        __syncthreads();
#pragma unroll
        for (int i = 0; i < 4; ++i) { const int id = tid + 512 * i, nn = id >> 3, ks = (id & 7) * 8, n = n0 + nn;
          if (n < N) { u32x4 o;
              o.x = pack2(tile[(ks + 0) * 257 + nn], tile[(ks + 1) * 257 + nn]); o.y = pack2(tile[(ks + 2) * 257 + nn], tile[(ks + 3) * 257 + nn]);
              o.z = pack2(tile[(ks + 4) * 257 + nn], tile[(ks + 5) * 257 + nn]); o.w = pack2(tile[(ks + 6) * 257 + nn], tile[(ks + 7) * 257 + nn]);
              *(u32x4*)(dst + (size_t)map_col(n, mode) * K + k0 + ks) = o; } }
        __syncthreads();
    }
    base += ntile;
}
__device__ __forceinline__ void cvt_rows_bf16(const float* __restrict__ src, bf16_t* __restrict__ dst, size_t n8) {
    const size_t stride = (size_t)gridDim.x * 512;
    for (size_t i = (size_t)lbid() * 512 + ltid(); i < n8; i += 4 * stride) {
        f32x4 a[4], b[4];
#pragma unroll
        for (int j = 0; j < 4; ++j) { const size_t k = i + j * stride; if (k < n8) { a[j] = __builtin_nontemporal_load((const f32x4*)(src + k * 8)); b[j] = __builtin_nontemporal_load((const f32x4*)(src + k * 8 + 4)); } }
#pragma unroll
        for (int j = 0; j < 4; ++j) { const size_t k = i + j * stride; if (k < n8) {
            u32x4 o; o.x = pack2(a[j][0], a[j][1]); o.y = pack2(a[j][2], a[j][3]); o.z = pack2(b[j][0], b[j][1]); o.w = pack2(b[j][2], b[j][3]);
            *(u32x4*)(dst + k * 8) = o; } }
    }
}
__device__ __forceinline__ void prologue_phase(const Params& p, unsigned char* lds) {
    float* tile = (float*)lds; unsigned char* ws = p.ws; int base = 0;
    for (int l = 0; l < 2; ++l) {
        transpose_job(p.in[2] + (size_t)l * DM * 3088, (bf16_t*)(ws + WS_WIN + l * SZ_WIN), DM, 3088, 1, tile, base);
        transpose_job(p.in[14] + (size_t)l * DM * DM, (bf16_t*)(ws + WS_WOUT + l * SZ_WOUT), DM, DM, 0, tile, base);
        transpose_job(p.in[17] + (size_t)l * DM * DFF, (bf16_t*)(ws + WS_WGU + l * SZ_WGU), DM, DFF, 2, tile, base);
        transpose_job(p.in[18] + (size_t)l * DM * DFF, (bf16_t*)(ws + WS_WGU + l * SZ_WGU), DM, DFF, 3, tile, base);
        transpose_job(p.in[19] + (size_t)l * DFF * DM, (bf16_t*)(ws + WS_WDN + l * SZ_WDN), DFF, DM, 0, tile, base);
        transpose_job(p.in[20] + (size_t)l * DM * DM, (bf16_t*)(ws + WS_WGU + l * SZ_WGU) + (size_t)2 * DFF * DM, DM, DM, 0, tile, base);
        transpose_job(p.in[21] + (size_t)l * PLE * DM, (bf16_t*)(ws + WS_WPP + l * SZ_WPP), PLE, DM, 0, tile, base);
        u32x4* z = (u32x4*)(ws + WS_WIN + l * SZ_WIN + (size_t)3088 * DM * 2);
        for (int i = lbid() * 512 + ltid(); i < 240 * DM / 8; i += gridDim.x * 512) z[i] = (u32x4){0u, 0u, 0u, 0u};
    }
    cvt_rows_bf16(p.in[0], (bf16_t*)(ws + WS_XB), (size_t)T_TOK * DM / 8);
    { bf16_t* wl = (bf16_t*)(ws + WS_WLRU);
      for (int i = lbid() * 512 + ltid(); i < 65536; i += gridDim.x * 512) {
          const int e = i & 7, ln = (i >> 3) & 63, ks = (i >> 9) & 1, nt = (i >> 10) & 1, dh = (i >> 11) & 1, g = (i >> 12) & 3, m = (i >> 14) & 1, l = i >> 15;
          const int d = dh * 32 + nt * 16 + (ln & 15), c = ks * 32 + (ln >> 4) * 8 + e;
          const float* src = (m == 0) ? p.in[9] : p.in[11]; wl[i] = f2bf(src[(size_t)l * 16384 + g * 4096 + c * 64 + d]); } }
}

__device__ __forceinline__ float wave_sum(float v) {
#pragma unroll
    for (int o = 32; o > 0; o >>= 1) v += __shfl_xor(v, o, 64);
    return v;
}
__device__ __forceinline__ void ln_phase(const float* zin, float* xout, bf16_t* xb, float* stats, const float* __restrict__ g, const float* __restrict__ bta) {
    const int tid_ = ltid(); const int lane = tid_ & 63, wave = tid_ >> 6;
    for (int row0 = lbid() * 16 + wave * 2; row0 < T_TOK; row0 += gridDim.x * 16) {
        f32x4 v[2][4]; float s[2] = {0.f, 0.f};
#pragma unroll
        for (int r = 0; r < 2; ++r) { const f32x4* zr = (const f32x4*)(zin + (size_t)(row0 + r) * DM);
#pragma unroll
            for (int i = 0; i < 4; ++i) v[r][i] = __builtin_nontemporal_load(zr + lane + 64 * i); }
#pragma unroll
        for (int r = 0; r < 2; ++r)
#pragma unroll
            for (int i = 0; i < 4; ++i) s[r] += v[r][i][0] + v[r][i][1] + v[r][i][2] + v[r][i][3];
        float mean[2], rstd[2];
#pragma unroll
        for (int r = 0; r < 2; ++r) { mean[r] = wave_sum(s[r]) * (1.0f / DM); float q = 0.f;
#pragma unroll
            for (int i = 0; i < 4; ++i) { v[r][i] = v[r][i] - mean[r]; q += v[r][i][0] * v[r][i][0] + v[r][i][1] * v[r][i][1] + v[r][i][2] * v[r][i][2] + v[r][i][3] * v[r][i][3]; }
            rstd[r] = 1.0f / sqrtf(wave_sum(q) * (1.0f / DM) + 1e-5f); }
        if (stats && lane < 2) { stats[2 * (row0 + lane)] = lane ? mean[1] : mean[0]; stats[2 * (row0 + lane) + 1] = lane ? rstd[1] : rstd[0]; }
#pragma unroll
        for (int i = 0; i < 4; ++i) { const f32x4 gg = ((const f32x4*)g)[lane + 64 * i], bb = ((const f32x4*)bta)[lane + 64 * i];
#pragma unroll
            for (int r = 0; r < 2; ++r) { const f32x4 o = v[r][i] * rstd[r] * gg + bb; const size_t rb = (size_t)(row0 + r) * DM;
                if (xout) ((f32x4*)(xout + rb))[lane + 64 * i] = o;
                if (xb) { u32x2 w; w.x = pack2(o[0], o[1]); w.y = pack2(o[2], o[3]); ((u32x2*)(xb + rb))[lane + 64 * i] = w; } } }
    }
}

constexpr int LDP = 72;
__device__ __forceinline__ f32x4 mma16(const bf16_t* A, int arow0, const bf16_t* Bt, int brow0, int ksteps, f32x4 acc, int lane) {
    const int r = lane & 15, g = lane >> 4;
    for (int kk = 0; kk < ksteps; ++kk) {
        const bf16x8 a = *(const bf16x8*)(A + (arow0 + r) * LDP + kk * 32 + g * 8);
        const bf16x8 b = *(const bf16x8*)(Bt + (brow0 + r) * LDP + kk * 32 + g * 8);
        acc = __builtin_amdgcn_mfma_f32_16x16x32_bf16(a, b, acc, 0, 0, 0);
    }
    return acc;
}

__device__ __forceinline__ void glr_item(int chunk, const bf16_t* XB, const bf16_t* WG  , float* LRB, unsigned char* lds) {
    f32x4* RED = (f32x4*)lds;
    const int tid = ltid(), lane = tid & 63, wave = tid >> 6, r16 = lane & 15, g4 = lane >> 4;
    const size_t tok0 = (size_t)chunk * 64;
    f32x4 acc[4];
#pragma unroll
    for (int mt = 0; mt < 4; ++mt) acc[mt] = (f32x4){0.f, 0.f, 0.f, 0.f};
#pragma unroll
    for (int ks = 0; ks < 4; ++ks) { const int k = wave * 128 + ks * 32 + g4 * 8;
        const bf16x8 bfr = *(const bf16x8*)(WG + (size_t)r16 * DM + k);
#pragma unroll
        for (int mt = 0; mt < 4; ++mt) { const bf16x8 afr = *(const bf16x8*)(XB + (tok0 + mt * 16 + r16) * DM + k);
            acc[mt] = __builtin_amdgcn_mfma_f32_16x16x32_bf16(afr, bfr, acc[mt], 0, 0, 0); } }
#pragma unroll
    for (int mt = 0; mt < 4; ++mt) RED[(wave * 4 + mt) * 64 + lane] = acc[mt];
    __syncthreads();
    if (tid < 256) { const int mt = tid >> 6; f32x4 s = RED[mt * 64 + lane];
#pragma unroll
        for (int w = 1; w < 8; ++w) s = s + RED[(w * 4 + mt) * 64 + lane];
#pragma unroll
        for (int i = 0; i < 4; ++i) LRB[(tok0 + mt * 16 + g4 * 4 + i) * 16 + r16] = s[i]; }
    __syncthreads();
}

constexpr int VTP = 68;
__device__ __forceinline__ void vtrans_item(int b, int n, const bf16_t* H, bf16_t* vT, bf16_t* KP, unsigned char* lds) {
    bf16_t* TT = (bf16_t*)lds;
    constexpr int KLP = 520;
    const int tid = ltid(); const size_t tok0 = (size_t)b * SEQ + (size_t)n * 64;
    u32x4 kw[8];
#pragma unroll
    for (int i = 0; i < 8; ++i) { const int vid = tid + 512 * i, seg = (vid & 7) | (((vid >> 6) & 7) << 3), t = ((vid >> 3) & 7) | ((vid >> 9) << 3), cs = seg * 8;
        const u32x4 w = __builtin_nontemporal_load((const u32x4*)(H + (tok0 + t) * DINP + 2048 + cs));
        kw[i] = __builtin_nontemporal_load((const u32x4*)(H + (tok0 + t) * DINP + 1536 + cs));
        TT[(cs + 0) * VTP + t] = (bf16_t)(w.x & 0xFFFFu); TT[(cs + 1) * VTP + t] = (bf16_t)(w.x >> 16);
        TT[(cs + 2) * VTP + t] = (bf16_t)(w.y & 0xFFFFu); TT[(cs + 3) * VTP + t] = (bf16_t)(w.y >> 16);
        TT[(cs + 4) * VTP + t] = (bf16_t)(w.z & 0xFFFFu); TT[(cs + 5) * VTP + t] = (bf16_t)(w.z >> 16);
        TT[(cs + 6) * VTP + t] = (bf16_t)(w.w & 0xFFFFu); TT[(cs + 7) * VTP + t] = (bf16_t)(w.w >> 16); }
    __syncthreads();
#pragma unroll
    for (int i = 0; i < 8; ++i) { const int vid = tid + 512 * i, ln = vid & 63, fr = (vid >> 6) & 7, hh = vid >> 9, r16 = ln & 15, g4 = ln >> 4, dt = fr >> 1, j = fr & 1;
        const bf16_t* src = TT + (hh * 64 + dt * 16 + r16) * VTP + j * 32 + g4 * 4;
        const u32x2 w0 = *(const u32x2*)src, w1 = *(const u32x2*)(src + 16);
        u32x4 w; w.x = w0.x; w.y = w0.y; w.z = w1.x; w.w = w1.y;
        *(u32x4*)(vT + ((((size_t)b * NCH + n) * 8 + hh) * 8 + fr) * 512 + ln * 8) = w; }
    __syncthreads();
#pragma unroll
    for (int i = 0; i < 8; ++i) { const int vid = tid + 512 * i, seg = (vid & 7) | (((vid >> 6) & 7) << 3), t = ((vid >> 3) & 7) | ((vid >> 9) << 3), cs = seg * 8;
        *(u32x4*)(TT + t * KLP + cs) = kw[i]; }
    __syncthreads();
#pragma unroll
    for (int i = 0; i < 8; ++i) { const int vid = tid + 512 * i, ln = vid & 63, fr = (vid >> 6) & 7, hh = vid >> 9, r16 = ln & 15, g4 = ln >> 4, kt = fr >> 1, ks = fr & 1;
        const u32x4 w = *(const u32x4*)(TT + (kt * 16 + r16) * KLP + hh * 64 + ks * 32 + g4 * 8);
        *(u32x4*)(KP + ((((size_t)b * NCH + n) * 8 + hh) * 8 + fr) * 512 + ln * 8) = w; }
    __syncthreads();
}

__device__ __forceinline__ void gla_item(int mode, int b, int n, int h, const bf16_t* H, const float* LRB, float* U, float* DEC, bf16_t* Y,
                         const float* __restrict__ w_up, const float* __restrict__ b_up, const float* __restrict__ norm_g, unsigned char* lds) {
    float* BC = (float*)lds;
    float* LR = BC + 64 * 65;
    float* TOT = LR + 1024;
    float* OF = TOT + 512;
    bf16_t* M0 = (bf16_t*)(OF + 64 * 65);
    bf16_t* M1 = M0 + 64 * LDP; bf16_t* M2 = M1 + 64 * LDP; bf16_t* M3 = M2 + 64 * LDP; bf16_t* M4 = M3 + 64 * LDP; bf16_t* M5 = M4 + 64 * LDP;
    const int tid = ltid(), lane = tid & 63, wave = tid >> 6;
    const size_t tok0 = (size_t)b * SEQ + (size_t)n * 64;
    const size_t cidx = ((size_t)b * NCH + n) * 4 + h;
    const int jr = lane, ds8 = wave * 8;
    const int rr = tid >> 3, cs8 = (tid & 7) * 8;
    u32x4 ld_kT, ld_vT, ld_q, ld_k, ld_g; f32x4 ld_s0, ld_s1;
    ld_vT = __builtin_nontemporal_load((const u32x4*)(H + (tok0 + rr) * DINP + 512 + h * 64 + cs8));
    float wu[16];
#pragma unroll
    for (int r = 0; r < 16; ++r) wu[r] = w_up[r * 256 + h * 64 + lane];
    const float bu = b_up[h * 64 + lane];
    if (mode == 0) { ld_kT = __builtin_nontemporal_load((const u32x4*)(H + (tok0 + rr) * DINP + 256 + h * 64 + cs8)); }
    else { ld_q = __builtin_nontemporal_load((const u32x4*)(H + (tok0 + rr) * DINP + 0 + h * 64 + cs8)); ld_k = __builtin_nontemporal_load((const u32x4*)(H + (tok0 + rr) * DINP + 256 + h * 64 + cs8));
           ld_s0 = __builtin_nontemporal_load((const f32x4*)(U + cidx * 4096 + (size_t)rr * 64 + cs8)); ld_s1 = __builtin_nontemporal_load((const f32x4*)(U + cidx * 4096 + (size_t)rr * 64 + cs8 + 4));
           ld_g = __builtin_nontemporal_load((const u32x4*)(H + (tok0 + rr) * DINP + 768 + h * 64 + cs8)); }
    LR[tid] = LRB[tok0 * 16 + tid]; LR[tid + 512] = LRB[tok0 * 16 + 512 + tid];
    bf16_t* NATV = (mode == 0) ? M3 : M5; bf16_t* NATK = M2;
    *(u32x4*)(NATV + rr * LDP + cs8) = ld_vT;
    if (mode == 0) *(u32x4*)(NATK + rr * LDP + cs8) = ld_kT;
    __syncthreads();
    { const int d = lane, tg = wave; float loc[8]; float run = 0.f;
#pragma unroll
      for (int i = 0; i < 8; ++i) { const int t = tg * 8 + i; float z = bu;
#pragma unroll
          for (int r = 0; r < 16; ++r) z += LR[t * 16 + r] * wu[r];
          const float ls = fminf(z, 0.f) - __logf(1.0f + __expf(-fabsf(z)));
          run += ls * (1.0f / 16.0f); loc[i] = run; }
      TOT[tg * 64 + d] = run;
      __syncthreads();
      float off = 0.f;
      for (int g2 = 0; g2 < tg; ++g2) off += TOT[g2 * 64 + d];
#pragma unroll
      for (int i = 0; i < 8; ++i) BC[(tg * 8 + i) * 65 + d] = loc[i] + off; }
    __syncthreads();
    if (mode == 0) {
        bf16_t* KdT = M0; bf16_t* VT = M1;
        { const int d = lane, j0 = wave * 8; float kd[8]; unsigned vr[8];
#pragma unroll
          for (int e = 0; e < 8; ++e) { kd[e] = bf2f(NATK[(j0 + e) * LDP + d]) * __expf(BC[63 * 65 + d] - BC[(j0 + e) * 65 + d]); vr[e] = NATV[(j0 + e) * LDP + d]; }
          u32x4 o; o.x = pack2(kd[0], kd[1]); o.y = pack2(kd[2], kd[3]); o.z = pack2(kd[4], kd[5]); o.w = pack2(kd[6], kd[7]); *(u32x4*)(KdT + d * LDP + j0) = o;
          o.x = vr[0] | (vr[1] << 16); o.y = vr[2] | (vr[3] << 16); o.z = vr[4] | (vr[5] << 16); o.w = vr[6] | (vr[7] << 16); *(u32x4*)(VT + d * LDP + j0) = o; }
        __syncthreads();
        { const int mt = wave >> 1;
#pragma unroll
          for (int q = 0; q < 2; ++q) { const int nt = (wave & 1) * 2 + q; f32x4 acc = {0.f, 0.f, 0.f, 0.f};
              acc = mma16(VT, mt * 16, KdT, nt * 16, 2, acc, lane);
#pragma unroll
              for (int i = 0; i < 4; ++i) U[cidx * 4096 + (size_t)(mt * 16 + (lane >> 4) * 4 + i) * 64 + nt * 16 + (lane & 15)] = acc[i]; } }
        if (tid < 64) DEC[cidx * 64 + tid] = __expf(BC[63 * 65 + tid]);
        __syncthreads();
        return;
    }
    bf16_t* Qe = M0; bf16_t* Ke = M1; bf16_t* VT = M2; bf16_t* Qb = M3; bf16_t* ST = M4; bf16_t* AT = M5;
    {
      const u32x4 qw = ld_q; const u32x4 kw = ld_k;
      const unsigned qq[4] = {qw.x, qw.y, qw.z, qw.w}, kk[4] = {kw.x, kw.y, kw.z, kw.w};
      float qe[8], qb[8], ke[8];
#pragma unroll
      for (int e = 0; e < 8; ++e) { const int d = cs8 + e; const float bc = BC[rr * 65 + d], rf = BC[32 * 65 + d];
          const float qf = ((e & 1) ? bfhi(qq[e >> 1]) : bflo(qq[e >> 1])) * 0.125f, kf = (e & 1) ? bfhi(kk[e >> 1]) : bflo(kk[e >> 1]);
          qe[e] = qf * __expf(bc - rf); qb[e] = qf * __expf(bc); ke[e] = kf * __expf(rf - bc); }
      u32x4 o; o.x = pack2(qe[0], qe[1]); o.y = pack2(qe[2], qe[3]); o.z = pack2(qe[4], qe[5]); o.w = pack2(qe[6], qe[7]); *(u32x4*)(Qe + rr * LDP + cs8) = o;
      o.x = pack2(qb[0], qb[1]); o.y = pack2(qb[2], qb[3]); o.z = pack2(qb[4], qb[5]); o.w = pack2(qb[6], qb[7]); *(u32x4*)(Qb + rr * LDP + cs8) = o;
      o.x = pack2(ke[0], ke[1]); o.y = pack2(ke[2], ke[3]); o.z = pack2(ke[4], ke[5]); o.w = pack2(ke[6], ke[7]); *(u32x4*)(Ke + rr * LDP + cs8) = o;
      const f32x4 s0 = ld_s0, s1 = ld_s1;
      o.x = pack2(s0[0], s0[1]); o.y = pack2(s0[2], s0[3]); o.z = pack2(s1[0], s1[1]); o.w = pack2(s1[2], s1[3]); *(u32x4*)(ST + rr * LDP + cs8) = o;
      { const int d = lane, j0 = wave * 8; unsigned vr[8];
#pragma unroll
        for (int e = 0; e < 8; ++e) vr[e] = NATV[(j0 + e) * LDP + d];
        u32x4 ov; ov.x = vr[0] | (vr[1] << 16); ov.y = vr[2] | (vr[3] << 16); ov.z = vr[4] | (vr[5] << 16); ov.w = vr[6] | (vr[7] << 16); *(u32x4*)(VT + d * LDP + j0) = ov; } }
    __syncthreads();
    const int mt = wave >> 1, g4 = lane >> 4, r16 = lane & 15;
#pragma unroll
    for (int q = 0; q < 2; ++q) { const int nt = (wave & 1) * 2 + q; f32x4 acc = {0.f, 0.f, 0.f, 0.f};
        acc = mma16(Qe, mt * 16, Ke, nt * 16, 2, acc, lane);
#pragma unroll
        for (int i = 0; i < 4; ++i) { const int ii = mt * 16 + g4 * 4 + i, jj = nt * 16 + r16; AT[ii * LDP + jj] = f2bf(jj <= ii ? acc[i] : 0.f); } }
    __syncthreads();
#pragma unroll
    for (int q = 0; q < 2; ++q) { const int nt = (wave & 1) * 2 + q; f32x4 acc = {0.f, 0.f, 0.f, 0.f};
        acc = mma16(AT, mt * 16, VT, nt * 16, 2, acc, lane);
        acc = mma16(Qb, mt * 16, ST, nt * 16, 2, acc, lane);
#pragma unroll
        for (int i = 0; i < 4; ++i) OF[(mt * 16 + g4 * 4 + i) * 65 + nt * 16 + r16] = acc[i]; }
    __syncthreads();
    { float o[8]; float ss = 0.f;
#pragma unroll
      for (int e = 0; e < 8; ++e) { o[e] = OF[rr * 65 + cs8 + e]; ss += o[e] * o[e]; }
      ss += __shfl_xor(ss, 1, 64); ss += __shfl_xor(ss, 2, 64); ss += __shfl_xor(ss, 4, 64);
      const float rs = 1.0f / sqrtf(ss * (1.0f / 64.0f) + 1e-6f);
      const u32x4 gw = ld_g;
      const unsigned gg[4] = {gw.x, gw.y, gw.z, gw.w};
#pragma unroll
      for (int e = 0; e < 8; ++e) { const float gf = (e & 1) ? bfhi(gg[e >> 1]) : bflo(gg[e >> 1]); o[e] = o[e] * rs * norm_g[cs8 + e] * siluf_(gf); }
      u32x4 w; w.x = pack2(o[0], o[1]); w.y = pack2(o[2], o[3]); w.z = pack2(o[4], o[5]); w.w = pack2(o[6], o[7]);
      *(u32x4*)(Y + (tok0 + rr) * DM + h * 64 + cs8) = w; }
    __syncthreads();
}
__device__ __forceinline__ void scan_phase(const float* __restrict__ U, float* __restrict__ SP, const float* __restrict__ DEC, const float* __restrict__ LA, const float* __restrict__ LH, float* __restrict__ LHIN) {
    const int tid = ltid(), bid = lbid();
    if (tid < 256) {
        for (int gt = bid * 256 + tid; gt < 65536; gt += (int)gridDim.x * 256) {
            const int bh = gt >> 12, vd = gt & 4095, b = bh >> 2, h = bh & 3, d = vd & 63;
            float st = 0.f;
            const size_t c0 = ((size_t)b * NCH) * 4 + h;
            for (int n0 = 0; n0 < NCH; n0 += 16) {
                float u[16], dc[16];
#pragma unroll
                for (int j = 0; j < 16; ++j) { const size_t c = c0 + (size_t)(n0 + j) * 4; u[j] = __builtin_nontemporal_load(U + c * 4096 + vd); dc[j] = DEC[c * 64 + d]; }
#pragma unroll
                for (int j = 0; j < 16; ++j) { const size_t c = c0 + (size_t)(n0 + j) * 4; SP[c * 4096 + vd] = st; st = dc[j] * st + u[j]; }
            }
        }
    } else {
        const int e = bid * 256 + (tid - 256);
        for (int e2 = e; e2 < 1024; e2 += (int)gridDim.x * 256) {
            const int b = e2 >> 8, c = e2 & 255; float st = 0.f;
            for (int n0 = 0; n0 < NCH; n0 += 16) {
                float a[16], hh[16];
#pragma unroll
                for (int j = 0; j < 16; ++j) { const size_t idx = ((size_t)b * NCH + n0 + j) * 256 + c; a[j] = LA[idx]; hh[j] = LH[idx]; }
#pragma unroll
                for (int j = 0; j < 16; ++j) { const size_t idx = ((size_t)b * NCH + n0 + j) * 256 + c; LHIN[idx] = st; st = a[j] * st + hh[j]; }
            }
        }
    }
}

constexpr int XBP = 264;
__device__ __forceinline__ void lru_item(int mode, int b, int n, const bf16_t* H, float* LA, float* LH, const float* LHIN, bf16_t* Y,
                         const float* __restrict__ conv_w, const float* __restrict__ conv_b, const bf16_t* __restrict__ WAT  , const float* __restrict__ b_a,
                         const float* __restrict__ b_i, const float* __restrict__ lam, unsigned char* lds) {
    float* XC = (float*)lds;
    bf16_t* XCb = (bf16_t*)(lds + 65536);
    bf16_t* LG = (bf16_t*)(lds + 65536 + 64 * XBP * 2);
    const int tid = ltid(), lane = tid & 63, wave = tid >> 6, r16 = lane & 15, g4 = lane >> 4;
    const size_t tok0 = (size_t)b * SEQ + (size_t)n * 64;
    const int gblk = wave >> 1, d0 = (wave & 1) * 32;
    const int cs = tid & 31, t0 = (tid >> 5) * 4;
    bf16x8 Wf[2][2][2];
#pragma unroll
    for (int m = 0; m < 2; ++m)
#pragma unroll
        for (int nt = 0; nt < 2; ++nt)
#pragma unroll
            for (int ks = 0; ks < 2; ++ks) Wf[m][nt][ks] = *(const bf16x8*)(WAT + (size_t)(((((m * 4 + gblk) * 2 + (wave & 1)) * 2 + nt) * 2 + ks) * 512 + lane * 8));
    u32x4 xr[7], gr[4];
#pragma unroll
    for (int j = 0; j < 7; ++j) { const int tk = t0 - 3 + j;
        xr[j] = (n > 0 || tk >= 0) ? __builtin_nontemporal_load((const u32x4*)(H + (size_t)((long)tok0 + tk) * DINP + 2560 + cs * 8)) : (u32x4){0u, 0u, 0u, 0u}; }
    if (mode == 1) {
#pragma unroll
        for (int tt = 0; tt < 4; ++tt) gr[tt] = __builtin_nontemporal_load((const u32x4*)(H + (tok0 + t0 + tt) * DINP + 2816 + cs * 8)); }
    f32x4 cw[4][2], cbv[2];
#pragma unroll
    for (int w = 0; w < 4; ++w) { cw[w][0] = *(const f32x4*)(conv_w + w * 256 + cs * 8); cw[w][1] = *(const f32x4*)(conv_w + w * 256 + cs * 8 + 4); }
    cbv[0] = *(const f32x4*)(conv_b + cs * 8); cbv[1] = *(const f32x4*)(conv_b + cs * 8 + 4);
#pragma unroll
    for (int tt = 0; tt < 4; ++tt) { float xc[8];
#pragma unroll
        for (int e2 = 0; e2 < 8; ++e2) { float acc = cbv[e2 >> 2][e2 & 3];
#pragma unroll
            for (int w = 0; w < 4; ++w) { const unsigned wd = xr[tt + w][e2 >> 1]; acc += cw[w][e2 >> 2][e2 & 3] * ((e2 & 1) ? bfhi(wd) : bflo(wd)); }
            xc[e2] = acc; }
        *(f32x4*)(XC + (t0 + tt) * 256 + cs * 8) = (f32x4){xc[0], xc[1], xc[2], xc[3]}; *(f32x4*)(XC + (t0 + tt) * 256 + cs * 8 + 4) = (f32x4){xc[4], xc[5], xc[6], xc[7]};
        u32x4 o; o.x = pack2(xc[0], xc[1]); o.y = pack2(xc[2], xc[3]); o.z = pack2(xc[4], xc[5]); o.w = pack2(xc[6], xc[7]);
        *(u32x4*)(XCb + (t0 + tt) * XBP + cs * 8) = o;
        if (mode == 1) *(u32x4*)(LG + (t0 + tt) * XBP + cs * 8) = gr[tt]; }
    __syncthreads();
    f32x4 R[4][2], I[4][2];
#pragma unroll
    for (int mt = 0; mt < 4; ++mt) {
        const bf16x8 a0 = *(const bf16x8*)(XCb + (mt * 16 + r16) * XBP + gblk * 64 + g4 * 8), a1 = *(const bf16x8*)(XCb + (mt * 16 + r16) * XBP + gblk * 64 + 32 + g4 * 8);
#pragma unroll
        for (int nt = 0; nt < 2; ++nt) { f32x4 z = {0.f, 0.f, 0.f, 0.f};
            z = __builtin_amdgcn_mfma_f32_16x16x32_bf16(a0, Wf[0][nt][0], z, 0, 0, 0); R[mt][nt] = __builtin_amdgcn_mfma_f32_16x16x32_bf16(a1, Wf[0][nt][1], z, 0, 0, 0);
            f32x4 y = {0.f, 0.f, 0.f, 0.f};
            y = __builtin_amdgcn_mfma_f32_16x16x32_bf16(a0, Wf[1][nt][0], y, 0, 0, 0); I[mt][nt] = __builtin_amdgcn_mfma_f32_16x16x32_bf16(a1, Wf[1][nt][1], y, 0, 0, 0); } }
#pragma unroll
    for (int nt = 0; nt < 2; ++nt) {
        const int ch = wave * 32 + nt * 16 + r16;
        const float ba = b_a[ch], bi = b_i[ch];
        const float ey = __expf(-lam[ch]); const float sp = (ey < 0.03f) ? ey * (1.0f - ey * (0.5f - ey * (0.33333333f - 0.25f * ey))) : __logf(1.0f + ey);
        const float csp = -8.0f * 1.4426950408889634f * sp;
        float Am[4], Hm[4];
#pragma unroll
        for (int mt = 0; mt < 4; ++mt) { float am = 1.f, hm = 0.f;
#pragma unroll
            for (int i = 0; i < 4; ++i) {
                const float d1 = 1.0f + __builtin_amdgcn_exp2f(fminf(-1.4426950408889634f * (R[mt][nt][i] + ba), 60.f)), d2 = 1.0f + __builtin_amdgcn_exp2f(fminf(-1.4426950408889634f * (I[mt][nt][i] + bi), 60.f));
                const float inv = __builtin_amdgcn_rcpf(d1 * d2); const float r = inv * d2, ig = inv * d1;
                const float a = __builtin_amdgcn_exp2f(csp * r); const float u = sqrtf(fmaf(-a, a, 1.0f)) * ig * XC[(mt * 16 + g4 * 4 + i) * 256 + ch];
                R[mt][nt][i] = a; I[mt][nt][i] = u; am *= a; hm = a * hm + u; }
            Am[mt] = am; Hm[mt] = hm; }
        const size_t aidx = ((size_t)b * NCH + n) * 256 + ch;
        if (mode == 0) {
            float cA = 1.f, cH = 0.f;
#pragma unroll
            for (int mt = 0; mt < 4; ++mt)
#pragma unroll
                for (int src = 0; src < 4; ++src) { const float As = __shfl(Am[mt], src * 16 + r16, 64), Hs = __shfl(Hm[mt], src * 16 + r16, 64); cH = As * cH + Hs; cA *= As; }
            if (g4 == 0) { LA[aidx] = cA; LH[aidx] = cH; }
        } else {
            float st = LHIN[aidx];
#pragma unroll
            for (int mt = 0; mt < 4; ++mt) { float sin_ = st;
#pragma unroll
                for (int src = 0; src < 4; ++src) { const float As = __shfl(Am[mt], src * 16 + r16, 64), Hs = __shfl(Hm[mt], src * 16 + r16, 64);
                    const float cand = As * sin_ + Hs; sin_ = (src < g4) ? cand : sin_; st = As * st + Hs; }
#pragma unroll
                for (int i = 0; i < 4; ++i) { sin_ = R[mt][nt][i] * sin_ + I[mt][nt][i]; const int t = mt * 16 + g4 * 4 + i;
                    const float gt = bf2f(LG[t * XBP + ch]); LG[t * XBP + ch] = f2bf(sin_ * gelu_tanh(gt)); } }
        }
    }
    __syncthreads();
    if (mode == 1) {
#pragma unroll
        for (int tt = 0; tt < 4; ++tt) *(u32x4*)(Y + (tok0 + t0 + tt) * DM + 768 + cs * 8) = *(const u32x4*)(LG + (t0 + tt) * XBP + cs * 8);
        __syncthreads();
    }
}

__device__ __forceinline__ void attn_item(int b, int n, int hg, const bf16_t* H, const bf16_t* vT, const bf16_t* KP, bf16_t* Y, const float* __restrict__ rel_bias, unsigned char* lds, int probe = 0, int never = 0) {
    const int tid = ltid(), lane = tid & 63, wv = tid >> 6, h = hg * 4 + (wv & 3), qh = wv >> 2, r16 = lane & 15, g4 = lane >> 4;
    const float* BT = (const float*)(lds + LDS_BT_OFF) + h * 520;
    const size_t tok0 = (size_t)b * SEQ + (size_t)n * 64;
    const int kb0 = (n >= 8) ? 0 : 8 - n;
    const float bfar = BT[512];
    bf16_t* WL = (bf16_t*)lds + wv * (32 * LDP);
    bf16x8 Qf[2][2];
    { u32x4 qw[4];
#pragma unroll
      for (int k = 0; k < 4; ++k) qw[k] = __builtin_nontemporal_load((const u32x4*)(H + (tok0 + qh * 32 + (lane >> 3) + 8 * k) * DINP + 1024 + h * 64 + (lane & 7) * 8));
#pragma unroll
      for (int k = 0; k < 4; ++k) *(u32x4*)(WL + ((lane >> 3) + 8 * k) * LDP + (lane & 7) * 8) = qw[k];
      asm volatile("s_waitcnt lgkmcnt(0)" ::: "memory"); __builtin_amdgcn_wave_barrier();
#pragma unroll
      for (int mt = 0; mt < 2; ++mt)
#pragma unroll
          for (int ks = 0; ks < 2; ++ks) Qf[mt][ks] = *(const bf16x8*)(WL + (mt * 16 + r16) * LDP + ks * 32 + g4 * 8);
      asm volatile("s_waitcnt lgkmcnt(0)" ::: "memory"); __builtin_amdgcn_wave_barrier(); }
    f32x4 OT[2][4]; float mrow[2], lrow[2];
#pragma unroll
    for (int mt = 0; mt < 2; ++mt) { mrow[mt] = -1e30f; lrow[mt] = 0.f;
#pragma unroll
        for (int dt = 0; dt < 4; ++dt) OT[mt][dt] = (f32x4){0.f, 0.f, 0.f, 0.f}; }
    bf16x8 Kf[4][2], Vf[4][2];
    const bf16_t* vrow = vT + ((size_t)b * NCH * 8 + h) * 4096 + lane * 8;
    const bf16_t* krow = KP + ((size_t)b * NCH * 8 + h) * 4096 + lane * 8;
    { const size_t kc = (size_t)(n - 8 + kb0) * 32768;
#pragma unroll
      for (int kt = 0; kt < 4; ++kt)
#pragma unroll
          for (int ks = 0; ks < 2; ++ks) Kf[kt][ks] = *(const bf16x8*)(krow + kc + (kt * 2 + ks) * 512);
#pragma unroll
      for (int dt = 0; dt < 4; ++dt)
#pragma unroll
          for (int j = 0; j < 2; ++j) Vf[dt][j] = *(const bf16x8*)(vrow + kc + (dt * 2 + j) * 512); }
    for (int kb = kb0; kb < 9; ++kb) {
        const int kbn = (kb + 1 < 9) ? kb + 1 : kb;
        const size_t kcn = (size_t)(n - 8 + (probe ? kb0 : kbn)) * 32768;
        f32x4 ST[4][2];
#pragma unroll
        for (int kt = 0; kt < 4; ++kt)
#pragma unroll
            for (int mt = 0; mt < 2; ++mt) { f32x4 a = {0.f, 0.f, 0.f, 0.f};
                a = __builtin_amdgcn_mfma_f32_16x16x32_bf16(Kf[kt][0], Qf[mt][0], a, 0, 0, 0);
                a = __builtin_amdgcn_mfma_f32_16x16x32_bf16(Kf[kt][1], Qf[mt][1], a, 0, 0, 0); ST[kt][mt] = a; }
        __builtin_amdgcn_sched_barrier(0);
#pragma unroll
        for (int kt = 0; kt < 4; ++kt)
#pragma unroll
            for (int ks = 0; ks < 2; ++ks) Kf[kt][ks] = *(const bf16x8*)(krow + kcn + (kt * 2 + ks) * 512);
        __builtin_amdgcn_sched_barrier(0);
        bf16x8 Pf[2][2];
#pragma unroll
        for (int mt = 0; mt < 2; ++mt) {
            float mx = -1e30f;
            constexpr float SC = 0.125f * 1.4426950408889634f;
            if (kb <= 3) {
#pragma unroll
                for (int kt = 0; kt < 4; ++kt)
#pragma unroll
                    for (int i = 0; i < 4; ++i) { const float s = ST[kt][mt][i] * SC + bfar; ST[kt][mt][i] = s; mx = fmaxf(mx, s); }
            } else {
                const int c0 = qh * 32 + mt * 16 + r16 - g4 * 4 + (8 - kb) * 64 + 256;
                if (kb == 4) {
#pragma unroll
                    for (int kt = 0; kt < 4; ++kt)
#pragma unroll
                        for (int i = 0; i < 4; ++i) { int idx = c0 - kt * 16 - i; idx = idx > 512 ? 512 : idx;
                            const float s = ST[kt][mt][i] * SC + BT[idx]; ST[kt][mt][i] = s; mx = fmaxf(mx, s); }
                } else {
                    const float* bp = BT + (c0 - 63);
#pragma unroll
                    for (int kt = 0; kt < 4; ++kt)
#pragma unroll
                        for (int i = 0; i < 4; ++i) { const float s = ST[kt][mt][i] * SC + bp[63 - kt * 16 - i]; ST[kt][mt][i] = s; mx = fmaxf(mx, s); }
                }
            }
            mx = fmaxf(mx, __shfl_xor(mx, 16, 64)); mx = fmaxf(mx, __shfl_xor(mx, 32, 64));
            const float mnew = fmaxf(mrow[mt], mx), alpha = __builtin_amdgcn_exp2f(mrow[mt] - mnew);
            float ps = 0.f;
#pragma unroll
            for (int kt = 0; kt < 4; ++kt)
#pragma unroll
                for (int i = 0; i < 4; ++i) { const float pv = __builtin_amdgcn_exp2f(ST[kt][mt][i] - mnew); ST[kt][mt][i] = pv; ps += pv; }
            lrow[mt] = lrow[mt] * alpha + ps; mrow[mt] = mnew;
#pragma unroll
            for (int dt = 0; dt < 4; ++dt) OT[mt][dt] = OT[mt][dt] * alpha;
#pragma unroll
            for (int j = 0; j < 2; ++j) { u32x4 w;
                w.x = pg8::cvt_pk_bf16(ST[2 * j][mt][0], ST[2 * j][mt][1]); w.y = pg8::cvt_pk_bf16(ST[2 * j][mt][2], ST[2 * j][mt][3]);
                w.z = pg8::cvt_pk_bf16(ST[2 * j + 1][mt][0], ST[2 * j + 1][mt][1]); w.w = pg8::cvt_pk_bf16(ST[2 * j + 1][mt][2], ST[2 * j + 1][mt][3]);
                Pf[mt][j] = __builtin_bit_cast(bf16x8, w); }
        }
#pragma unroll
        for (int dt = 0; dt < 4; ++dt)
#pragma unroll
            for (int j = 0; j < 2; ++j) { const bf16x8 vf = Vf[dt][j];
#pragma unroll
                for (int mt = 0; mt < 2; ++mt) OT[mt][dt] = __builtin_amdgcn_mfma_f32_16x16x32_bf16(vf, Pf[mt][j], OT[mt][dt], 0, 0, 0); }
        __builtin_amdgcn_sched_barrier(0);
#pragma unroll
        for (int dt = 0; dt < 4; ++dt)
#pragma unroll
            for (int j = 0; j < 2; ++j) Vf[dt][j] = *(const bf16x8*)(vrow + kcn + (dt * 2 + j) * 512);
        __builtin_amdgcn_sched_barrier(0);
    }
#pragma unroll
    for (int mt = 0; mt < 2; ++mt) { float l = lrow[mt]; l += __shfl_xor(l, 16, 64); l += __shfl_xor(l, 32, 64);
        const float inv = 1.0f / l;
#pragma unroll
        for (int dt = 0; dt < 4; ++dt) { u32x2 w; w.x = pg8::cvt_pk_bf16(OT[mt][dt][0] * inv, OT[mt][dt][1] * inv); w.y = pg8::cvt_pk_bf16(OT[mt][dt][2] * inv, OT[mt][dt][3] * inv);
            *(u32x2*)(WL + (mt * 16 + r16) * LDP + dt * 16 + g4 * 4) = w; } }
    asm volatile("s_waitcnt lgkmcnt(0)" ::: "memory"); __builtin_amdgcn_wave_barrier();
    if (!probe || never) {
#pragma unroll
        for (int k = 0; k < 4; ++k) { const int row = (lane >> 3) + 8 * k; const u32x4 v = *(const u32x4*)(WL + row * LDP + (lane & 7) * 8);
            *(u32x4*)(Y + (tok0 + qh * 32 + row) * DM + 256 + h * 64 + (lane & 7) * 8) = v; } }
    asm volatile("s_waitcnt lgkmcnt(0)" ::: "memory"); __builtin_amdgcn_wave_barrier();
}

#ifndef DUPMASK
#define DUPMASK 0
#endif
#define GSYNC() do { xcd_barrier(xbar); if (DUPMASK & 512) xcd_barrier(xbar); } while (0)
struct Ptrs { unsigned char* ws; bf16_t* XB; bf16_t* PB; bf16_t* R1; float* X1; bf16_t* VT; float* U; float* SP; bf16_t* KP; float* ST1; float* ST2; float* LRB; float* DEC; float* LA; float* LH; float* LHIN; };
__device__ __forceinline__ Ptrs mkptrs(const Params& p) { Ptrs q; unsigned char* ws = p.ws; q.ws = ws;
    q.XB = (bf16_t*)(ws + WS_XB); q.PB = (bf16_t*)(ws + WS_PB); q.R1 = (bf16_t*)(ws + WS_R1); q.X1 = (float*)(ws + WS_X1); unsigned char* ob = (unsigned char*)p.out; q.VT = (bf16_t*)(ob + X1_VT); q.U = (float*)(ob + X1_U); q.SP = (float*)(ob + X1_SP); q.KP = (bf16_t*)(ob + X1_KP); q.ST1 = (float*)(ws + WS_ST); q.ST2 = q.ST1 + 2 * T_TOK; q.LRB = (float*)(ws + WS_LRB);
    q.DEC = (float*)(ws + WS_SM); q.LA = q.DEC + 131072; q.LH = q.LA + 131072; q.LHIN = q.LH + 131072; return q; }

__global__ void __launch_bounds__(512, 2) fwd_megakernel(Params p_unused) {
    extern __shared__ __attribute__((aligned(16))) unsigned char lds[];
    cg::grid_group grid = cg::this_grid();
    { volatile LAS unsigned* st = (volatile LAS unsigned*)((LAS unsigned char*)lds + LDS_BAR_OFF);
      if (threadIdx.x < 4) st[threadIdx.x] = 0u; }
    __syncthreads();
    XcdBarrier xbar;
    { const Params p = fresh_params(); xbar = xcd_barrier_post((unsigned*)(p.ws + WS_BAR), (volatile LAS unsigned*)((LAS unsigned char*)lds + LDS_BAR_OFF)); }
    for (int rep_ = 0; rep_ < ((DUPMASK & 8192) ? 2 : 1); ++rep_) { const Params p = fresh_params(); prologue_phase(p, lds); }
    if (p_unused.ws == nullptr) grid.sync();
    xcd_barrier(xbar);

#pragma unroll 1
    for (int l = 0; l < 2; ++l) {
        for (int rep_ = 0; rep_ < ((DUPMASK & 257) ? 2 : 1); ++rep_) { const Params p = fresh_params(); const Ptrs q = mkptrs(p);
          EpiStoreBf16 E; E.O = q.R1; E.ldc = DINP; run_gemm(lds, q.XB, (const bf16_t*)(q.ws + WS_WIN + l * SZ_WIN), 3072, DM, E);
          for (int c = lbid(); c < T_TOK / 64; c += gridDim.x) glr_item(c, q.XB, (const bf16_t*)(q.ws + WS_WIN + l * SZ_WIN) + (size_t)3072 * DM, q.LRB, lds); }
        GSYNC();
        for (int rep_ = 0; rep_ < ((DUPMASK & 2) ? 2 : 1); ++rep_) { const Params p = fresh_params(); const Ptrs q = mkptrs(p); const int G = gridDim.x;
          for (int it = lbid(); it < 3072; it += G) {
            if (it < 512) for (int r2 = 0; r2 < ((DUPMASK & 32) ? 2 : 1); ++r2) lru_item(0, it >> 7, it & 127, q.R1, q.LA, q.LH, q.LHIN, q.XB, p.in[7] + l * 1024, p.in[8] + l * 256, (const bf16_t*)(q.ws + WS_WLRU) + (size_t)l * 32768, p.in[10] + l * 256, p.in[12] + l * 256, p.in[13] + l * 256, lds);
            else if (it < 2560) for (int r2 = 0; r2 < ((DUPMASK & 64) ? 2 : 1); ++r2) { const int e = it - 512; gla_item(0, e >> 9, (e >> 2) & 127, e & 3, q.R1, q.LRB, q.U, q.DEC, q.XB, p.in[3] + l * 4096, p.in[4] + l * 256, p.in[5] + l * 64, lds); }
            else for (int r2 = 0; r2 < ((DUPMASK & 128) ? 2 : 1); ++r2) { const int e = it - 2560; vtrans_item(e >> 7, e & 127, q.R1, q.VT, q.KP, lds); }
          } }
        GSYNC();
        for (int rep_ = 0; rep_ < ((DUPMASK & 4) ? 2 : 1); ++rep_) { const Params p = fresh_params(); const Ptrs q = mkptrs(p); scan_phase(q.U, q.SP, q.DEC, q.LA, q.LH, q.LHIN); }
        GSYNC();
        { const Params p = fresh_params(); const int t = ltid(); float* bt = (float*)(lds + LDS_BT_OFF); float v[9];
#pragma unroll
          for (int i = 0; i < 9; ++i) { const int e = t + 512 * i; v[i] = (e < 8 * 513) ? p.in[6][e] : 0.f; }
#pragma unroll
          for (int i = 0; i < 9; ++i) { const int e = t + 512 * i; if (e < 8 * 513) bt[(e / 513) * 520 + (e % 513)] = v[i] * 1.4426950408889634f; }
          __syncthreads(); }
        for (int rep_ = 0; rep_ < ((DUPMASK & 2) ? 2 : 1); ++rep_) { const Params p = fresh_params(); const Ptrs q = mkptrs(p); const int G = gridDim.x;
          for (int it = lbid(); it < 3584; it += G) {
            if (it < 1024) for (int r2 = 0; r2 < ((DUPMASK & 16) ? 2 : 1); ++r2) { const int sl = (it & 255) >> 3; const int ai = (G == 256) ? ((it & 7) * 64 + (it >> 8) * 16 + (sl >> 1)) : (it >> 1); const int hg = (G == 256) ? (sl & 1) : (it & 1); attn_item(ai >> 7, ai & 127, hg, q.R1, q.VT, q.KP, q.XB, p.in[6], lds, (DUPMASK & 1024) ? r2 : 0, l > 100); }
            else if (it < 1536) for (int r2 = 0; r2 < ((DUPMASK & 32) ? 2 : 1); ++r2) { const int e = it - 1024; __syncthreads();     lru_item(1, e >> 7, e & 127, q.R1, q.LA, q.LH, q.LHIN, q.XB, p.in[7] + l * 1024, p.in[8] + l * 256, (const bf16_t*)(q.ws + WS_WLRU) + (size_t)l * 32768, p.in[10] + l * 256, p.in[12] + l * 256, p.in[13] + l * 256, lds); }
            else for (int r2 = 0; r2 < ((DUPMASK & 64) ? 2 : 1); ++r2) { const int e = it - 1536; gla_item(1, e >> 9, (e >> 2) & 127, e & 3, q.R1, q.LRB, q.SP, q.DEC, q.XB, p.in[3] + l * 4096, p.in[4] + l * 256, p.in[5] + l * 64, lds); }
          } }
        GSYNC();
        for (int rep_ = 0; rep_ < (((DUPMASK & 1) && l == 0) ? 2 : 1); ++rep_) { const Params p = fresh_params(); const Ptrs q = mkptrs(p);
          if (l == 0) { EpiF32<0> E; E.C = q.X1; E.R = p.in[0]; E.P = nullptr; E.ST = nullptr; E.g = nullptr; E.b = nullptr; run_gemm(lds, q.XB, (const bf16_t*)(q.ws + WS_WOUT + l * SZ_WOUT), DM, DM, E); }
          else { EpiF32<4> E; E.C = q.X1; E.R = nullptr; E.P = nullptr; E.ST = q.ST2; E.g = p.in[22]; E.b = p.in[23]; run_gemm(lds, q.XB, (const bf16_t*)(q.ws + WS_WOUT + l * SZ_WOUT), DM, DM, E); } }
        GSYNC();
        for (int rep_ = 0; rep_ < ((DUPMASK & 2048) ? 2 : 1); ++rep_) { const Params p = fresh_params(); const Ptrs q = mkptrs(p);
          ln_phase(q.X1, nullptr, q.XB, q.ST1, p.in[15] + l * DM, p.in[16] + l * DM);
          cvt_rows_bf16(p.in[1] + (size_t)l * T_TOK * PLE, q.PB, (size_t)T_TOK * PLE / 8); }
        GSYNC();
        for (int rep_ = 0; rep_ < ((DUPMASK & 4096) ? 2 : 1); ++rep_) { const Params p = fresh_params(); const Ptrs q = mkptrs(p);
          EpiGUPG E; E.O = q.R1; E.PL = p.out; run_gemm(lds, q.XB, (const bf16_t*)(q.ws + WS_WGU + l * SZ_WGU), 2 * DFF + DM, DM, E); }
        GSYNC();
        for (int rep_ = 0; rep_ < ((DUPMASK & 16384) ? 2 : 1); ++rep_) {
        { const Params p = fresh_params(); const Ptrs q = mkptrs(p);
          EpiF32<2> E; E.nostore = ((DUPMASK & 16384) && rep_ == 0) ? 1 : 0; E.PPB = q.XB; E.C = nullptr; E.R = nullptr; E.P = nullptr; E.ST = nullptr; E.g = nullptr; E.b = nullptr; run_gemm(lds, q.PB, (const bf16_t*)(q.ws + WS_WPP + l * SZ_WPP), DM, PLE, E); }
        { const Params p = fresh_params(); const Ptrs q = mkptrs(p);
          EpiF32<5> E; E.nostore = ((DUPMASK & 16384) && rep_ == 0) ? 1 : 0; E.PPB = q.XB; E.C = q.X1; E.R = nullptr; E.P = p.out; E.ST = q.ST1; E.g = p.in[15] + l * DM; E.b = p.in[16] + l * DM; run_gemm(lds, q.R1, (const bf16_t*)(q.ws + WS_WDN + l * SZ_WDN), DM, DFF, E); } }
        GSYNC();
        for (int rep_ = 0; rep_ < ((DUPMASK & 8) ? 2 : 1); ++rep_) { const Params p = fresh_params(); const Ptrs q = mkptrs(p);
          if (l == 0) ln_phase(q.X1, nullptr, q.XB, q.ST2, p.in[22], p.in[23]);
          else ln_phase(q.X1, p.out, nullptr, nullptr, p.in[22] + DM, p.in[23] + DM); }
        if (l == 0) GSYNC();
    }
}

extern "C" void kernel_launch(void* const* d_in, const int* in_sizes, int n_in, void* d_out, int out_size, void* d_ws, size_t ws_size, hipStream_t stream) {
    constexpr int kLds = LDS_BT_OFF + 8 * 520 * 4;
    static int grid_blocks = 0;
    if (grid_blocks == 0) {
        if (n_in != 24 || out_size != T_TOK * DM || ws_size < WS_END) { fprintf(stderr, "kernel_launch: unexpected shapes (n_in %d out %d ws %zu need %zu)\n", n_in, out_size, ws_size, (size_t)WS_END); grid_blocks = -1; return; }
        int dev = 0, cus = 0, per_cu = 0;
        hipGetDevice(&dev);
        hipDeviceGetAttribute(&cus, hipDeviceAttributeMultiprocessorCount, dev);
        if (hipFuncSetAttribute((const void*)fwd_megakernel, hipFuncAttributeMaxDynamicSharedMemorySize, kLds) != hipSuccess) { fprintf(stderr, "kernel_launch: hipFuncSetAttribute failed\n"); grid_blocks = -1; return; }
        if (hipOccupancyMaxActiveBlocksPerMultiprocessor(&per_cu, (const void*)fwd_megakernel, 512, kLds) != hipSuccess || per_cu < 1) { fprintf(stderr, "kernel_launch: occupancy query says %d\n", per_cu); per_cu = 1; (void)hipGetLastError(); }
        if (per_cu > 1) per_cu = 1;
        grid_blocks = cus * per_cu;
    }
    if (grid_blocks < 0) return;
    if (hipMemsetAsync((unsigned char*)d_ws + WS_BAR, 0, XCD_BAR_WORDS * 4, stream) != hipSuccess) { fprintf(stderr, "kernel_launch: memset of the barrier words failed\n"); return; }
    Params p{};
    for (int i = 0; i < 24; ++i) p.in[i] = (const float*)d_in[i];
    p.out = (float*)d_out; p.ws = (unsigned char*)d_ws;
    void* args[] = {&p};
    hipError_t e = hipLaunchCooperativeKernel((const void*)fwd_megakernel, dim3(grid_blocks), dim3(512), args, kLds, stream);
    if (e != hipSuccess) fprintf(stderr, "cooperative launch failed: %s (grid %d)\n", hipGetErrorString(e), grid_blocks);
}
```

```cpp
#include <hip/hip_runtime.h>
#include <hip/hip_cooperative_groups.h>
#include <cstdio>
namespace cg = cooperative_groups;

constexpr int T_TOK = 32768, SEQ = 8192, NB = 4, NCH = 128, DM = 1024, DINP = 3328, DFF = 2816, PLE = 256;
constexpr float DN_ALPHA = 1.41421356237309515f;
constexpr size_t SZ_WIN = (size_t)DINP * DM * 2, SZ_WOUT = (size_t)DM * DM * 2, SZ_WGU = (size_t)(2 * DFF + DM) * DM * 2, SZ_WDN = (size_t)DM * DFF * 2, SZ_WPG = (size_t)DM * DM * 2, SZ_WPP = (size_t)DM * PLE * 2;
constexpr size_t WS_WIN = 0;
constexpr size_t WS_WOUT = WS_WIN + 2 * SZ_WIN;
constexpr size_t WS_WGU = WS_WOUT + 2 * SZ_WOUT;
constexpr size_t WS_WDN = WS_WGU + 2 * SZ_WGU;
constexpr size_t WS_WPP = WS_WDN + 2 * SZ_WDN;
constexpr size_t WS_XB = WS_WPP + 2 * SZ_WPP;
constexpr size_t WS_PB = WS_XB + (size_t)T_TOK * DM * 2;
constexpr size_t WS_R1 = WS_PB + (size_t)T_TOK * PLE * 2;
constexpr size_t WS_X1 = WS_R1 + (size_t)T_TOK * DINP * 2;
constexpr size_t WS_SM = WS_X1 + (size_t)T_TOK * DM * 4;
constexpr size_t WS_WLRU = WS_SM + 4 * 524288;
constexpr size_t WS_BAR = WS_WLRU + 131072;
constexpr size_t WS_ST = WS_BAR + 16384;
constexpr size_t WS_LRB = WS_ST + (size_t)4 * T_TOK * 4;
constexpr size_t WS_END = WS_LRB + (size_t)T_TOK * 16 * 4;
constexpr size_t X1_VT = 0, X1_U = (size_t)T_TOK * 512 * 2, X1_SP = X1_U + (size_t)NB * NCH * 4 * 4096 * 4, X1_KP = X1_SP + (size_t)NB * NCH * 4 * 4096 * 4;

typedef unsigned short bf16_t;
typedef unsigned u32x4 __attribute__((ext_vector_type(4)));
typedef unsigned u32x2 __attribute__((ext_vector_type(2)));

__device__ __forceinline__ bf16_t f2bf(float f) { unsigned u = __float_as_uint(f); u += 0x7FFFu + ((u >> 16) & 1u); return (bf16_t)(u >> 16); }
__device__ __forceinline__ float bf2f(bf16_t b) { return __uint_as_float(((unsigned)b) << 16); }
__device__ __forceinline__ unsigned pack2(float lo, float hi) { return (unsigned)f2bf(lo) | ((unsigned)f2bf(hi) << 16); }
__device__ __forceinline__ float bflo(unsigned w) { return __uint_as_float(w << 16); }
__device__ __forceinline__ float bfhi(unsigned w) { return __uint_as_float(w & 0xFFFF0000u); }
__device__ __forceinline__ float sigmoidf_(float x) { return __builtin_amdgcn_rcpf(1.0f + __builtin_amdgcn_exp2f(-1.4426950408889634f * x)); }
__device__ __forceinline__ float siluf_(float x) { return x * __builtin_amdgcn_rcpf(1.0f + __builtin_amdgcn_exp2f(-1.4426950408889634f * x)); }
__device__ __forceinline__ float gelu_tanh(float x) { const float u = 0.7978845608028654f * (x + 0.044715f * x * x * x); const float e = __builtin_amdgcn_exp2f(2.8853900817779268f * u); const float th = 1.0f - 2.0f * __builtin_amdgcn_rcpf(e + 1.0f); return 0.5f * x * (1.0f + th); }

struct Params { const float* in[24]; float* out; unsigned char* ws; };


__device__ __forceinline__ int ltid() { int t = threadIdx.x; asm volatile("" : "+v"(t)); return t; }
__device__ __forceinline__ int lbid() { int t = blockIdx.x; asm volatile("" : "+s"(t)); return t; }
__device__ __forceinline__ Params fresh_params() {
    const __attribute__((address_space(4))) Params* kp = (const __attribute__((address_space(4))) Params*)__builtin_amdgcn_kernarg_segment_ptr();
    asm volatile("" : "+s"(kp)); Params r;
#pragma unroll
    for (int i = 0; i < 24; ++i) r.in[i] = kp->in[i];
    r.out = kp->out; r.ws = kp->ws; return r; }
__device__ __forceinline__ float neg_expm1(float t) { return (t > -0.5f) ? -t * (1.0f + t * (0.5f + t * (0.16666667f + t * (0.041666668f + t * (0.0083333338f + t * 0.0013888889f))))) : 1.0f - __expf(t); }
constexpr int LDS_BAR_OFF = 134912;
constexpr int LDS_BT_OFF = LDS_BAR_OFF + 256;
namespace pg8 {
#define PG8_LAS __attribute__((address_space(3)))
typedef unsigned short bf16_t;
typedef short bf16x8 __attribute__((ext_vector_type(8)));
typedef float f32x4 __attribute__((ext_vector_type(4)));
typedef unsigned u32x4 __attribute__((ext_vector_type(4)));
constexpr int BM = 256, BK = 64, HALF = 128, HTB = HALF * BK * 2  , STAGE_BYTES = 8 * HTB, NXCD = 8, WGM = 8;

__host__ __device__ __forceinline__ int lds_byte(int r, int c) { const int st = (r >> 4) * 2 + (c >> 5), rr = r & 15, cc = c & 31, ob = rr * 64 + cc * 2; return st * 1024 + (ob ^ (((ob >> 9) & 1) << 5)); }
__host__ __device__ __forceinline__ void stage_rc(int b, int& R, int& C) { const int st = b / 1024, sb = b % 1024, swz = sb ^ (((sb >> 9) & 1) << 5); R = (st >> 1) * 16 + swz / 64; C = (st & 1) * 32 + (swz % 64) / 2; }
__host__ __device__ __forceinline__ int perm32(int rho) { const int n = rho >> 4, i = rho & 15; return 8 * (i >> 2) + 4 * n + (i & 3); }

struct Unit { int pm, pn; };
struct Gemm { const bf16_t* A; const bf16_t* Bt; int M, N, K; };

struct StaticOrder {
    int nM, nN, nwg, G, c;
    __host__ __device__ void init(int M, int N, int G_, int c_) { nM = M / BM; nN = N / BM; nwg = nM * nN; G = G_; c = c_; }
    __host__ __device__ bool next(int i, Unit& u) const {
        const long L = (long)i * G + c; if (L >= nwg) return false;
        int wgid = (int)L; { const int q = nwg / NXCD, r = nwg % NXCD, xcd = wgid % NXCD, off = wgid / NXCD; wgid = (xcd < r ? xcd * (q + 1) : r * (q + 1) + (xcd - r) * q) + off; }
        const int nig = WGM * nN, gid = wgid / nig, fm = gid * WGM, gsz = (nM - fm) < WGM ? (nM - fm) : WGM;
        u.pm = fm + ((wgid % nig) % gsz); u.pn = (wgid % nig) / gsz; return true;
    }
    __device__ __forceinline__ void a_ready(const Unit&) const {}
    __device__ __forceinline__ void done(const Unit&) const {}
};
__device__ __forceinline__ unsigned cvt_pk_bf16(float lo, float hi) { unsigned r; asm volatile("v_cvt_pk_bf16_f32 %0, %1, %2" : "=v"(r) : "v"(lo), "v"(hi)); return r; }
typedef float f32x2 __attribute__((ext_vector_type(2)));
template <class Epi, class Sched, bool STAMP = false>
__device__ __forceinline__ void gemm_phase(PG8_LAS unsigned char* lds, const Gemm g, const Sched& S, const Epi& E, unsigned long long* stamps) {
    const int tid = ltid(), wid = __builtin_amdgcn_readfirstlane(tid >> 6), lane = tid & 63, wr = wid >> 2, wc = wid & 3, fr = lane & 15, fq = lane >> 4;
    const int K = g.K, nt = K / BK;
    int ts_lo = 0, ts_hi = 0, nts = 0; const unsigned long long rt_entry = STAMP ? (unsigned long long)wall_clock64() : 0ull;
#define PG8_STAMP() do { if (STAMP && wid == 0 && nts < 64) { const unsigned long long _c = (unsigned long long)clock64(); \
        ts_lo = (lane == nts) ? (int)(unsigned)_c : ts_lo; ts_hi = (lane == nts) ? (int)(unsigned)(_c >> 32) : ts_hi; ++nts; } } while (0)
    PG8_STAMP();
    unsigned voffA[2], voffB[2];
#pragma unroll
    for (int i = 0; i < 2; ++i) { int R, C; stage_rc(tid * 16 + i * 8192, R, C); const int Rb = Epi::PERM ? ((R & ~31) + perm32(R & 31)) : R;
        voffA[i] = (unsigned)(R * K + C) * 2u; voffB[i] = (unsigned)(Rb * K + C) * 2u; }
    const size_t kstep = (size_t)(BK * 2);
    const size_t hstep = (size_t)HALF * K * 2;
    const size_t tstep = 2 * hstep;
    const unsigned ldsw = (unsigned)wid * 1024u;
    const int aoff = lds_byte(wr * 64 + fr, fq * 8), boff = lds_byte(wc * 32 + fr, fq * 8);
#define PG8_SA(b, h) (((b) * 2 + (h)) * HTB)
#define PG8_SB(b, h) ((4 + (b) * 2 + (h)) * HTB)
#define PG8_STAGE(bufoff, gbase, voff) do { _Pragma("unroll") for (int _i = 0; _i < 2; ++_i) \
        __builtin_amdgcn_global_load_lds((const unsigned*)((const char*)(gbase) + (voff)[_i]), (PG8_LAS unsigned*)(lds + (bufoff) + ldsw + _i * 8192), 16, 0, 0); } while (0)
#define PG8_LDA(dst, b, h) do { _Pragma("unroll") for (int m = 0; m < 4; ++m) _Pragma("unroll") for (int k = 0; k < 2; ++k) dst[m][k] = *(const PG8_LAS bf16x8*)(lds + PG8_SA(b, h) + aoff + m * 2048 + k * 1024); } while (0)
#define PG8_LDB(dst, b, h) do { _Pragma("unroll") for (int n = 0; n < 2; ++n) _Pragma("unroll") for (int k = 0; k < 2; ++k) dst[n][k] = *(const PG8_LAS bf16x8*)(lds + PG8_SB(b, h) + boff + n * 2048 + k * 1024); } while (0)
#define PG8_MMA(ai, bj, At, Bt) do { __builtin_amdgcn_s_setprio(1); _Pragma("unroll") for (int m = 0; m < 4; ++m) _Pragma("unroll") for (int n = 0; n < 2; ++n) _Pragma("unroll") for (int k = 0; k < 2; ++k) \
        acc[ai][bj][m][n] = __builtin_amdgcn_mfma_f32_16x16x32_bf16(Bt[n][k], At[m][k], acc[ai][bj][m][n], 0, 0, 0); __builtin_amdgcn_s_setprio(0); } while (0)
#define PG8_WAIT_V(n) asm volatile("s_waitcnt vmcnt(" #n ")" ::: "memory")
#define PG8_WAIT_L(n) asm volatile("s_waitcnt lgkmcnt(" #n ")" ::: "memory")
#define PG8_BAR __builtin_amdgcn_s_barrier()
#define PG8_SCHED __builtin_amdgcn_sched_barrier(0)
    Unit cur, nxt; int ui = 0;
    if (!S.next(0, cur)) return;
    f32x4 acc[2][2][4][2];
#pragma unroll
    for (int a = 0; a < 2; ++a)
#pragma unroll
        for (int b = 0; b < 2; ++b)
#pragma unroll
            for (int m = 0; m < 4; ++m)
#pragma unroll
                for (int n = 0; n < 2; ++n) acc[a][b][m][n] = (f32x4){0.f, 0.f, 0.f, 0.f};
    bf16x8 At[4][2], B0[2][2], B1[2][2];
    const char* cA = (const char*)g.A + (size_t)cur.pm * tstep; const char* cB = (const char*)g.Bt + (size_t)cur.pn * tstep;
    S.a_ready(cur);
    PG8_STAGE(PG8_SB(0, 0), cB, voffB); PG8_STAGE(PG8_SA(0, 0), cA, voffA); PG8_STAGE(PG8_SB(0, 1), cB + hstep, voffB); PG8_STAGE(PG8_SA(0, 1), cA + hstep, voffA);
    if (wr == 1) PG8_BAR;
    PG8_WAIT_V(4); PG8_BAR;
    PG8_STAGE(PG8_SB(1, 0), cB + kstep, voffB); PG8_STAGE(PG8_SA(1, 0), cA + kstep, voffA); PG8_STAGE(PG8_SB(1, 1), cB + hstep + kstep, voffB);
    PG8_WAIT_V(6); PG8_BAR;
    PG8_STAMP();
    for (;;) {
        const bool has_next = S.next(ui + 1, nxt);
        const char* nA = has_next ? (const char*)g.A + (size_t)nxt.pm * tstep : cA; const char* nB = has_next ? (const char*)g.Bt + (size_t)nxt.pn * tstep : cB;
        for (int t = 0; t < nt; t += 2) {
            const bool last = (t == nt - 2);
            const char* a1 = cA + (size_t)(t + 1) * kstep;
            const char* a2 = last ? nA : cA + (size_t)(t + 2) * kstep; const char* b2 = last ? nB : cB + (size_t)(t + 2) * kstep;
            const char* a3 = a2 + kstep; const char* b3 = b2 + kstep;
            if (last && has_next) S.a_ready(nxt);
            PG8_LDB(B0, 0, 0); PG8_SCHED; PG8_LDA(At, 0, 0); PG8_STAGE(PG8_SA(1, 1), a1 + hstep, voffA);
            PG8_WAIT_L(8); PG8_BAR; PG8_WAIT_L(0); PG8_MMA(0, 0, At, B0); PG8_BAR; PG8_SCHED;
            PG8_LDB(B1, 0, 1); PG8_STAGE(PG8_SB(0, 0), b2, voffB);
            PG8_BAR; PG8_WAIT_L(0); PG8_MMA(0, 1, At, B1); PG8_BAR;
            PG8_LDA(At, 0, 1); PG8_STAGE(PG8_SA(0, 0), a2, voffA);
            PG8_BAR; PG8_WAIT_L(0); PG8_MMA(1, 0, At, B0); PG8_BAR; PG8_SCHED;
            PG8_STAGE(PG8_SB(0, 1), b2 + hstep, voffB);
            PG8_WAIT_V(6); PG8_BAR; PG8_MMA(1, 1, At, B1); PG8_BAR;
            PG8_LDB(B0, 1, 0); PG8_SCHED; PG8_LDA(At, 1, 0); PG8_STAGE(PG8_SA(0, 1), a2 + hstep, voffA);
            PG8_WAIT_L(8); PG8_BAR; PG8_WAIT_L(0); PG8_MMA(0, 0, At, B0); PG8_BAR; PG8_SCHED;
            PG8_LDB(B1, 1, 1); PG8_STAGE(PG8_SB(1, 0), b3, voffB);
            PG8_BAR; PG8_WAIT_L(0); PG8_MMA(0, 1, At, B1); PG8_BAR;
            PG8_LDA(At, 1, 1); PG8_STAGE(PG8_SA(1, 0), a3, voffA);
            PG8_BAR; PG8_WAIT_L(0); PG8_MMA(1, 0, At, B0); PG8_BAR; PG8_SCHED;
            PG8_STAGE(PG8_SB(1, 1), b3 + hstep, voffB);
            PG8_WAIT_V(6); PG8_BAR; PG8_MMA(1, 1, At, B1); PG8_BAR;
        }
        PG8_STAMP();
        if constexpr (!Epi::AFTER_DRAIN) { E(acc, cur, wr, wc, fr, fq); S.done(cur); }
        PG8_STAMP();
        if (!has_next) break;
#pragma unroll
        for (int a = 0; a < 2; ++a)
#pragma unroll
            for (int b = 0; b < 2; ++b)
#pragma unroll
                for (int m = 0; m < 4; ++m)
#pragma unroll
                    for (int n = 0; n < 2; ++n) acc[a][b][m][n] = (f32x4){0.f, 0.f, 0.f, 0.f};
        cur = nxt; cA = nA; cB = nB; ++ui;
    }
    PG8_WAIT_V(0);
    if (wr == 0) PG8_BAR;
    PG8_BAR;
    if constexpr (Epi::AFTER_DRAIN) { E.fused(acc, cur, wr, wc, fr, fq, lds, wid, lane); S.done(cur); }
    PG8_STAMP();
    if (STAMP && wid == 0) { stamps[lane] = lane < nts ? (((unsigned long long)(unsigned)ts_hi << 32) | (unsigned)ts_lo) : 0ull;
        if (lane == 62) stamps[62] = rt_entry; if (lane == 63) stamps[63] = (unsigned long long)wall_clock64(); }
#undef PG8_STAMP
#undef PG8_SA
#undef PG8_SB
#undef PG8_STAGE
#undef PG8_LDA
#undef PG8_LDB
#undef PG8_MMA
#undef PG8_WAIT_V
#undef PG8_WAIT_L
#undef PG8_BAR
#undef PG8_SCHED
}
}
#define LAS __attribute__((address_space(3)))
#define XB_TMO      128
#define XB_XCNT(j)  (256  + 64 * (j))
#define XB_XSUB(j)  (1280 + 64 * (j))
#define XB_XGEN(j)  (2304 + 64 * (j))
#define XB_TOP      3328
#define XB_TOPGEN   3392
#define XCD_BAR_WORDS 3456
#define XB_SPIN_CAP (1u << 18)

__device__ __forceinline__ unsigned xb_ld(unsigned* p)              { return __hip_atomic_load(p, __ATOMIC_RELAXED, __HIP_MEMORY_SCOPE_AGENT); }
__device__ __forceinline__ unsigned xb_add(unsigned* p, unsigned v) { return __hip_atomic_fetch_add(p, v, __ATOMIC_RELAXED, __HIP_MEMORY_SCOPE_AGENT); }
__device__ __forceinline__ unsigned xb_xcc_id() { return (unsigned)__builtin_amdgcn_s_getreg((3 << 11) | 20) & 0xFu; }
#define XB_SPIN(cond, bar) do { unsigned _sp = 0; while (cond) { __builtin_amdgcn_s_sleep(1); \
    if ((++_sp & 255u) == 0u) { if (xb_ld(&(bar)[XB_TMO])) break; if (_sp > XB_SPIN_CAP) { atomicAdd(&(bar)[XB_TMO], 1u); break; } } } } while (0)

struct XcdBarrier {
    unsigned* bar; unsigned x;
    volatile LAS unsigned* st;
};

__device__ __forceinline__ XcdBarrier xcd_barrier_post(unsigned* bar, volatile LAS unsigned* st) {
    XcdBarrier b; b.bar = bar; b.x = xb_xcc_id(); b.st = st;
    if (threadIdx.x == 0) (void)xb_add(&bar[XB_XCNT(b.x)], 1u);
    return b;
}
__device__ __forceinline__ void xcd_barrier_complete(unsigned* bar, unsigned x, unsigned& nloc, unsigned& nx) {
    const unsigned G = gridDim.x * gridDim.y * gridDim.z;
    unsigned sum, cnt, mine, sp = 0u;
    for (;;) {
        sum = 0u; cnt = 0u; mine = 0u;
#pragma unroll
        for (unsigned j = 0; j < 16; ++j) { const unsigned c = xb_ld(&bar[XB_XCNT(j)]); sum += c; cnt += (c > 0u) ? 1u : 0u; mine = (j == x) ? c : mine; }
        if (sum == G) break;
        __builtin_amdgcn_s_sleep(1);
        if ((++sp & 255u) == 0u) { if (xb_ld(&bar[XB_TMO])) break; if (sp > XB_SPIN_CAP) { atomicAdd(&bar[XB_TMO], 1u); break; } }
    }
    nloc = mine > 0u ? mine : 1u; nx = cnt > 0u ? cnt : 1u;
}

__device__ __forceinline__ void xcd_barrier(const XcdBarrier& b) {
    asm volatile("s_waitcnt vmcnt(0)" ::: "memory");
    __syncthreads();
    if (threadIdx.x == 0) {
        unsigned* bar = b.bar;
        __builtin_amdgcn_s_waitcnt(0);
        unsigned nloc = b.st[0], nx = b.st[1];
        if (nloc == 0u) { xcd_barrier_complete(bar, b.x, nloc, nx); b.st[0] = nloc; b.st[1] = nx; }
        const unsigned old = xb_add(&bar[XB_XSUB(b.x)], 1u);
        const unsigned gen = old / nloc;
        if (old + 1u == (gen + 1u) * nloc) {
            __builtin_amdgcn_fence(__ATOMIC_RELEASE, "agent");
            asm volatile("s_waitcnt vmcnt(0)" ::: "memory");
            const unsigned og = xb_add(&bar[XB_TOP], 1u);
            const unsigned tg = og / nx;
            if (og + 1u == (tg + 1u) * nx) xb_add(&bar[XB_TOPGEN], 1u);
            else XB_SPIN(xb_ld(&bar[XB_TOPGEN]) == tg, bar);
            __builtin_amdgcn_fence(__ATOMIC_ACQUIRE, "agent");
            xb_add(&bar[XB_XGEN(b.x)], 1u);
            asm volatile("s_waitcnt vmcnt(0)" ::: "memory");
        } else {
            XB_SPIN(xb_ld(&bar[XB_XGEN(b.x)]) == gen, bar);
            __builtin_amdgcn_fence(__ATOMIC_ACQUIRE, "agent");
            asm volatile("s_waitcnt vmcnt(0)" ::: "memory");
        }
    }
    __syncthreads();
}


using pg8::bf16x8; using pg8::f32x4; using pg8::Unit;

struct EpiStoreBf16 {
    static constexpr bool PERM = true, AFTER_DRAIN = false;
    bf16_t* O; int ldc;
    __device__ __forceinline__ void operator()(const f32x4 (&acc)[2][2][4][2], const Unit& u, int wr, int wc, int fr, int fq) const {
        const int row0 = u.pm * 256 + wr * 64 + fr, col0 = u.pn * 256 + wc * 32 + 8 * fq;
#pragma unroll
        for (int ai = 0; ai < 2; ++ai)
#pragma unroll
            for (int m = 0; m < 4; ++m) { bf16_t* rowp = O + (size_t)(row0 + ai * 128 + m * 16) * ldc + col0;
#pragma unroll
                for (int bj = 0; bj < 2; ++bj) { const f32x4 v0 = acc[ai][bj][m][0], v1 = acc[ai][bj][m][1];
                    u32x4 o; o.x = pg8::cvt_pk_bf16(v0[0], v0[1]); o.y = pg8::cvt_pk_bf16(v0[2], v0[3]); o.z = pg8::cvt_pk_bf16(v1[0], v1[1]); o.w = pg8::cvt_pk_bf16(v1[2], v1[3]);
                    *(u32x4*)(rowp + bj * 128) = o; } }
    }
};
struct EpiGUPG {
    static constexpr bool PERM = true, AFTER_DRAIN = false;
    bf16_t* O; float* PL;
    __device__ __forceinline__ void operator()(const f32x4 (&acc)[2][2][4][2], const Unit& u, int wr, int wc, int fr, int fq) const {
        const int row0 = u.pm * 256 + wr * 64 + fr;
        if (u.pn < 22) {
            const int col0 = u.pn * 128 + wc * 32 + 8 * fq;
#pragma unroll
            for (int ai = 0; ai < 2; ++ai)
#pragma unroll
                for (int m = 0; m < 4; ++m) { bf16_t* rowp = O + (size_t)(row0 + ai * 128 + m * 16) * DFF + col0;
                    float h[8];
#pragma unroll
                    for (int n = 0; n < 2; ++n)
#pragma unroll
                        for (int j = 0; j < 4; j += 2) {
                            const float g1 = acc[ai][0][m][n][j], g2 = acc[ai][0][m][n][j + 1];
                            const float t1 = 1.0f + __builtin_amdgcn_exp2f(fminf(-1.4426950408889634f * g1, 60.f)), t2 = 1.0f + __builtin_amdgcn_exp2f(fminf(-1.4426950408889634f * g2, 60.f));
                            const float inv = __builtin_amdgcn_rcpf(t1 * t2);
                            h[n * 4 + j] = g1 * acc[ai][1][m][n][j] * (inv * t2); h[n * 4 + j + 1] = g2 * acc[ai][1][m][n][j + 1] * (inv * t1); }
                    u32x4 o; o.x = pg8::cvt_pk_bf16(h[0], h[1]); o.y = pg8::cvt_pk_bf16(h[2], h[3]); o.z = pg8::cvt_pk_bf16(h[4], h[5]); o.w = pg8::cvt_pk_bf16(h[6], h[7]);
                    *(u32x4*)rowp = o; }
        } else {
            const int col0 = (u.pn - 22) * 256 + wc * 32 + 8 * fq;
#pragma unroll
            for (int ai = 0; ai < 2; ++ai)
#pragma unroll
                for (int m = 0; m < 4; ++m) { float* rowp = PL + (size_t)(row0 + ai * 128 + m * 16) * DM + col0;
#pragma unroll
                    for (int bj = 0; bj < 2; ++bj)
#pragma unroll
                        for (int n = 0; n < 2; ++n) { const f32x4 a = acc[ai][bj][m][n]; f32x4 o; o[0] = sigmoidf_(a[0]); o[1] = sigmoidf_(a[1]); o[2] = sigmoidf_(a[2]); o[3] = sigmoidf_(a[3]);
                            *(f32x4*)(rowp + bj * 128 + 4 * n) = o; } }
        }
    }
};
template <int MODE> struct EpiF32 {
    static constexpr bool PERM = false, AFTER_DRAIN = false;
    float* C; const float* R; const float* P; const float* ST; const float* g; const float* b; int nostore = 0; bf16_t* PPB = nullptr;
    __device__ __forceinline__ void operator()(const f32x4 (&acc)[2][2][4][2], const Unit& u, int wr, int wc, int fr, int fq) const {
        const int row0 = u.pm * 256 + wr * 64 + fr, col0 = u.pn * 256 + wc * 32 + 4 * fq;
        f32x4 gv[2][2], bv[2][2];
        if (MODE >= 4) {
#pragma unroll
            for (int bj = 0; bj < 2; ++bj)
#pragma unroll
                for (int n = 0; n < 2; ++n) { gv[bj][n] = *(const f32x4*)(g + col0 + bj * 128 + n * 16); bv[bj][n] = *(const f32x4*)(b + col0 + bj * 128 + n * 16); } }
#pragma unroll
        for (int ai = 0; ai < 2; ++ai)
#pragma unroll
            for (int m = 0; m < 4; ++m) { const int row = row0 + ai * 128 + m * 16; const size_t rb = (size_t)row * DM + col0;
                float mean = 0.f, rstd = 0.f;
                if (MODE >= 4) { mean = ST[2 * row]; rstd = ST[2 * row + 1]; }
#pragma unroll
                for (int bj = 0; bj < 2; ++bj)
#pragma unroll
                    for (int n = 0; n < 2; ++n) { const size_t idx = rb + bj * 128 + n * 16; const f32x4 a = acc[ai][bj][m][n]; f32x4 o;
                        if (MODE == 0) { const f32x4 r = *(const f32x4*)(R + idx); o = r * DN_ALPHA + a; }
                        else if (MODE == 2) { u32x2 w; w.x = pg8::cvt_pk_bf16(a[0], a[1]); w.y = pg8::cvt_pk_bf16(a[2], a[3]); if (!nostore) *(u32x2*)(PPB + idx) = w; continue; }
                        else { const f32x4 z = *(const f32x4*)(C + idx); const f32x4 x = (z - mean) * rstd * gv[bj][n] + bv[bj][n]; o = x * DN_ALPHA + a;
                               if (MODE == 5) { const f32x4 sg = *(const f32x4*)(P + idx); const u32x2 c = *(const u32x2*)(PPB + idx);
                                   o[0] += sg[0] * bflo(c.x); o[1] += sg[1] * bfhi(c.x); o[2] += sg[2] * bflo(c.y); o[3] += sg[3] * bfhi(c.y); } }
                        if (!nostore) *(f32x4*)(C + idx) = o; } }
    }
};

template <class Epi> __device__ __forceinline__ void run_gemm(unsigned char* lds, const bf16_t* A, const bf16_t* Bt, int N, int K, const Epi& E) {
    pg8::Gemm g; g.A = A; g.Bt = Bt; g.M = T_TOK; g.N = N; g.K = K;
    pg8::StaticOrder S; S.init(T_TOK, N, (int)gridDim.x, lbid());
    pg8::gemm_phase<Epi, pg8::StaticOrder, false>((LAS unsigned char*)lds, g, S, E, nullptr);
    __syncthreads();
}

__device__ __forceinline__ int map_col(int n, int mode) {
    if (mode == 1) return n < 1024 ? n : (n < 1040 ? n - 1024 + 3072 : n - 16);
    if (mode == 2) return (n >> 7) * 256 + (n & 127);
    if (mode == 3) return (n >> 7) * 256 + 128 + (n & 127);
    return n;
}
__device__ __forceinline__ void transpose_job(const float* __restrict__ src, bf16_t* __restrict__ dst, int K, int N, int mode, float* tile, int& base) {
    const int tid = ltid(), G = gridDim.x;
    const int ntn = (N + 255) >> 8, ntile = (K >> 6) * ntn;
    int t0 = ((int)blockIdx.x - (base % G) + G) % G;
    for (int t = t0; t < ntile; t += G) {
        const int k0 = (t / ntn) << 6, n0 = (t % ntn) << 8;
        f32x4 v[8];
#pragma unroll
        for (int i = 0; i < 8; ++i) { const int kk = (tid >> 6) + 8 * i, nn = (tid & 63) * 4, n = n0 + nn;
            v[i] = (n < N) ? __builtin_nontemporal_load((const f32x4*)(src + (size_t)(k0 + kk) * N + n)) : (f32x4){0.f, 0.f, 0.f, 0.f}; }
#pragma unroll
        for (int i = 0; i < 8; ++i) { const int kk = (tid >> 6) + 8 * i, nn = (tid & 63) * 4;
            tile[kk * 257 + nn] = v[i][0]; tile[kk * 257 + nn + 1] = v[i][1]; tile[kk * 257 + nn + 2] = v[i][2]; tile[kk * 257 + nn + 3] = v[i][3]; }
        __syncthreads();
#pragma unroll
        for (int i = 0; i < 4; ++i) { const int id = tid + 512 * i, nn = id >> 3, ks = (id & 7) * 8, n = n0 + nn;
          if (n < N) { u32x4 o;
              o.x = pack2(tile[(ks + 0) * 257 + nn], tile[(ks + 1) * 257 + nn]); o.y = pack2(tile[(ks + 2) * 257 + nn], tile[(ks + 3) * 257 + nn]);
              o.z = pack2(tile[(ks + 4) * 257 + nn], tile[(ks + 5) * 257 + nn]); o.w = pack2(tile[(ks + 6) * 257 + nn], tile[(ks + 7) * 257 + nn]);
              *(u32x4*)(dst + (size_t)map_col(n, mode) * K + k0 + ks) = o; } }
        __syncthreads();
    }
    base += ntile;
}
__device__ __forceinline__ void cvt_rows_bf16(const float* __restrict__ src, bf16_t* __restrict__ dst, size_t n8) {
    const size_t stride = (size_t)gridDim.x * 512;
    for (size_t i = (size_t)lbid() * 512 + ltid(); i < n8; i += 4 * stride) {
        f32x4 a[4], b[4];
#pragma unroll
        for (int j = 0; j < 4; ++j) { const size_t k = i + j * stride; if (k < n8) { a[j] = __builtin_nontemporal_load((const f32x4*)(src + k * 8)); b[j] = __builtin_nontemporal_load((const f32x4*)(src + k * 8 + 4)); } }
#pragma unroll
        for (int j = 0; j < 4; ++j) { const size_t k = i + j * stride; if (k < n8) {
            u32x4 o; o.x = pack2(a[j][0], a[j][1]); o.y = pack2(a[j][2], a[j][3]); o.z = pack2(b[j][0], b[j][1]); o.w = pack2(b[j][2], b[j][3]);
            *(u32x4*)(dst + k * 8) = o; } }
    }
}
__device__ __forceinline__ void prologue_phase(const Params& p, unsigned char* lds) {
    float* tile = (float*)lds; unsigned char* ws = p.ws; int base = 0;
    for (int l = 0; l < 2; ++l) {
        transpose_job(p.in[2] + (size_t)l * DM * 3088, (bf16_t*)(ws + WS_WIN + l * SZ_WIN), DM, 3088, 1, tile, base);
        transpose_job(p.in[14] + (size_t)l * DM * DM, (bf16_t*)(ws + WS_WOUT + l * SZ_WOUT), DM, DM, 0, tile, base);
        transpose_job(p.in[17] + (size_t)l * DM * DFF, (bf16_t*)(ws + WS_WGU + l * SZ_WGU), DM, DFF, 2, tile, base);
        transpose_job(p.in[18] + (size_t)l * DM * DFF, (bf16_t*)(ws + WS_WGU + l * SZ_WGU), DM, DFF, 3, tile, base);
        transpose_job(p.in[19] + (size_t)l * DFF * DM, (bf16_t*)(ws + WS_WDN + l * SZ_WDN), DFF, DM, 0, tile, base);
        transpose_job(p.in[20] + (size_t)l * DM * DM, (bf16_t*)(ws + WS_WGU + l * SZ_WGU) + (size_t)2 * DFF * DM, DM, DM, 0, tile, base);
        transpose_job(p.in[21] + (size_t)l * PLE * DM, (bf16_t*)(ws + WS_WPP + l * SZ_WPP), PLE, DM, 0, tile, base);
        u32x4* z = (u32x4*)(ws + WS_WIN + l * SZ_WIN + (size_t)3088 * DM * 2);
        for (int i = lbid() * 512 + ltid(); i < 240 * DM / 8; i += gridDim.x * 512) z[i] = (u32x4){0u, 0u, 0u, 0u};
    }
    cvt_rows_bf16(p.in[0], (bf16_t*)(ws + WS_XB), (size_t)T_TOK * DM / 8);
    { bf16_t* wl = (bf16_t*)(ws + WS_WLRU);
      for (int i = lbid() * 512 + ltid(); i < 65536; i += gridDim.x * 512) {
          const int e = i & 7, ln = (i >> 3) & 63, ks = (i >> 9) & 1, nt = (i >> 10) & 1, dh = (i >> 11) & 1, g = (i >> 12) & 3, m = (i >> 14) & 1, l = i >> 15;
          const int d = dh * 32 + nt * 16 + (ln & 15), c = ks * 32 + (ln >> 4) * 8 + e;
          const float* src = (m == 0) ? p.in[9] : p.in[11]; wl[i] = f2bf(src[(size_t)l * 16384 + g * 4096 + c * 64 + d]); } }
}

__device__ __forceinline__ float wave_sum(float v) {
#pragma unroll
    for (int o = 32; o > 0; o >>= 1) v += __shfl_xor(v, o, 64);
    return v;
}
__device__ __forceinline__ void ln_phase(const float* zin, float* xout, bf16_t* xb, float* stats, const float* __restrict__ g, const float* __restrict__ bta) {
    const int tid_ = ltid(); const int lane = tid_ & 63, wave = tid_ >> 6;
    for (int row0 = lbid() * 16 + wave * 2; row0 < T_TOK; row0 += gridDim.x * 16) {
        f32x4 v[2][4]; float s[2] = {0.f, 0.f};
#pragma unroll
        for (int r = 0; r < 2; ++r) { const f32x4* zr = (const f32x4*)(zin + (size_t)(row0 + r) * DM);
#pragma unroll
            for (int i = 0; i < 4; ++i) v[r][i] = __builtin_nontemporal_load(zr + lane + 64 * i); }
#pragma unroll
        for (int r = 0; r < 2; ++r)
#pragma unroll
            for (int i = 0; i < 4; ++i) s[r] += v[r][i][0] + v[r][i][1] + v[r][i][2] + v[r][i][3];
        float mean[2], rstd[2];
#pragma unroll
        for (int r = 0; r < 2; ++r) { mean[r] = wave_sum(s[r]) * (1.0f / DM); float q = 0.f;
#pragma unroll
            for (int i = 0; i < 4; ++i) { v[r][i] = v[r][i] - mean[r]; q += v[r][i][0] * v[r][i][0] + v[r][i][1] * v[r][i][1] + v[r][i][2] * v[r][i][2] + v[r][i][3] * v[r][i][3]; }
            rstd[r] = 1.0f / sqrtf(wave_sum(q) * (1.0f / DM) + 1e-5f); }
        if (stats && lane < 2) { stats[2 * (row0 + lane)] = lane ? mean[1] : mean[0]; stats[2 * (row0 + lane) + 1] = lane ? rstd[1] : rstd[0]; }
#pragma unroll
        for (int i = 0; i < 4; ++i) { const f32x4 gg = ((const f32x4*)g)[lane + 64 * i], bb = ((const f32x4*)bta)[lane + 64 * i];
#pragma unroll
            for (int r = 0; r < 2; ++r) { const f32x4 o = v[r][i] * rstd[r] * gg + bb; const size_t rb = (size_t)(row0 + r) * DM;
                if (xout) __builtin_nontemporal_store(o, (f32x4*)(xout + rb) + lane + 64 * i);
                if (xb) { u32x2 w; w.x = pack2(o[0], o[1]); w.y = pack2(o[2], o[3]); ((u32x2*)(xb + rb))[lane + 64 * i] = w; } } }
    }
}

constexpr int LDP = 72;
__device__ __forceinline__ f32x4 mma16(const bf16_t* A, int arow0, const bf16_t* Bt, int brow0, int ksteps, f32x4 acc, int lane) {
    const int r = lane & 15, g = lane >> 4;
    for (int kk = 0; kk < ksteps; ++kk) {
        const bf16x8 a = *(const bf16x8*)(A + (arow0 + r) * LDP + kk * 32 + g * 8);
        const bf16x8 b = *(const bf16x8*)(Bt + (brow0 + r) * LDP + kk * 32 + g * 8);
        acc = __builtin_amdgcn_mfma_f32_16x16x32_bf16(a, b, acc, 0, 0, 0);
    }
    return acc;
}

__device__ __forceinline__ void glr_item(int chunk, const bf16_t* XB, const bf16_t* WG  , float* LRB, unsigned char* lds) {
    f32x4* RED = (f32x4*)lds;
    const int tid = ltid(), lane = tid & 63, wave = tid >> 6, r16 = lane & 15, g4 = lane >> 4;
    const size_t tok0 = (size_t)chunk * 64;
    f32x4 acc[4];
#pragma unroll
    for (int mt = 0; mt < 4; ++mt) acc[mt] = (f32x4){0.f, 0.f, 0.f, 0.f};
#pragma unroll
    for (int ks = 0; ks < 4; ++ks) { const int k = wave * 128 + ks * 32 + g4 * 8;
        const bf16x8 bfr = *(const bf16x8*)(WG + (size_t)r16 * DM + k);
#pragma unroll
        for (int mt = 0; mt < 4; ++mt) { const bf16x8 afr = *(const bf16x8*)(XB + (tok0 + mt * 16 + r16) * DM + k);
            acc[mt] = __builtin_amdgcn_mfma_f32_16x16x32_bf16(afr, bfr, acc[mt], 0, 0, 0); } }
#pragma unroll
    for (int mt = 0; mt < 4; ++mt) RED[(wave * 4 + mt) * 64 + lane] = acc[mt];
    __syncthreads();
    if (tid < 256) { const int mt = tid >> 6; f32x4 s = RED[mt * 64 + lane];
#pragma unroll
        for (int w = 1; w < 8; ++w) s = s + RED[(w * 4 + mt) * 64 + lane];
#pragma unroll
        for (int i = 0; i < 4; ++i) LRB[(tok0 + mt * 16 + g4 * 4 + i) * 16 + r16] = s[i]; }
    __syncthreads();
}

constexpr int VTP = 68;
__device__ __forceinline__ void vtrans_item(int b, int n, const bf16_t* H, bf16_t* vT, bf16_t* KP, unsigned char* lds) {
    bf16_t* TT = (bf16_t*)lds;
    constexpr int KLP = 520;
    const int tid = ltid(); const size_t tok0 = (size_t)b * SEQ + (size_t)n * 64;
    u32x4 kw[8];
#pragma unroll
    for (int i = 0; i < 8; ++i) { const int vid = tid + 512 * i, seg = (vid & 7) | (((vid >> 6) & 7) << 3), t = ((vid >> 3) & 7) | ((vid >> 9) << 3), cs = seg * 8;
        const u32x4 w = __builtin_nontemporal_load((const u32x4*)(H + (tok0 + t) * DINP + 2048 + cs));
        kw[i] = __builtin_nontemporal_load((const u32x4*)(H + (tok0 + t) * DINP + 1536 + cs));
        TT[(cs + 0) * VTP + t] = (bf16_t)(w.x & 0xFFFFu); TT[(cs + 1) * VTP + t] = (bf16_t)(w.x >> 16);
        TT[(cs + 2) * VTP + t] = (bf16_t)(w.y & 0xFFFFu); TT[(cs + 3) * VTP + t] = (bf16_t)(w.y >> 16);
        TT[(cs + 4) * VTP + t] = (bf16_t)(w.z & 0xFFFFu); TT[(cs + 5) * VTP + t] = (bf16_t)(w.z >> 16);
        TT[(cs + 6) * VTP + t] = (bf16_t)(w.w & 0xFFFFu); TT[(cs + 7) * VTP + t] = (bf16_t)(w.w >> 16); }
    __syncthreads();
#pragma unroll
    for (int i = 0; i < 8; ++i) { const int vid = tid + 512 * i, ln = vid & 63, fr = (vid >> 6) & 7, hh = vid >> 9, r16 = ln & 15, g4 = ln >> 4, dt = fr >> 1, j = fr & 1;
        const bf16_t* src = TT + (hh * 64 + dt * 16 + r16) * VTP + j * 32 + g4 * 4;
        const u32x2 w0 = *(const u32x2*)src, w1 = *(const u32x2*)(src + 16);
        u32x4 w; w.x = w0.x; w.y = w0.y; w.z = w1.x; w.w = w1.y;
        *(u32x4*)(vT + ((((size_t)b * NCH + n) * 8 + hh) * 8 + fr) * 512 + ln * 8) = w; }
    __syncthreads();
#pragma unroll
    for (int i = 0; i < 8; ++i) { const int vid = tid + 512 * i, seg = (vid & 7) | (((vid >> 6) & 7) << 3), t = ((vid >> 3) & 7) | ((vid >> 9) << 3), cs = seg * 8;
        *(u32x4*)(TT + t * KLP + cs) = kw[i]; }
    __syncthreads();
#pragma unroll
    for (int i = 0; i < 8; ++i) { const int vid = tid + 512 * i, ln = vid & 63, fr = (vid >> 6) & 7, hh = vid >> 9, r16 = ln & 15, g4 = ln >> 4, kt = fr >> 1, ks = fr & 1;
        const u32x4 w = *(const u32x4*)(TT + (kt * 16 + r16) * KLP + hh * 64 + ks * 32 + g4 * 8);
        *(u32x4*)(KP + ((((size_t)b * NCH + n) * 8 + hh) * 8 + fr) * 512 + ln * 8) = w; }
    __syncthreads();
}

__device__ __forceinline__ void gla_item(int mode, int b, int n, int h, const bf16_t* H, const float* LRB, float* U, float* DEC, bf16_t* Y,
                         const float* __restrict__ w_up, const float* __restrict__ b_up, const float* __restrict__ norm_g, unsigned char* lds) {
    float* BC = (float*)lds;
    float* LR = BC + 64 * 65;
    float* TOT = LR + 1024;
    float* OF = TOT + 512;
    bf16_t* M0 = (bf16_t*)(OF + 64 * 65);
    bf16_t* M1 = M0 + 64 * LDP; bf16_t* M2 = M1 + 64 * LDP; bf16_t* M3 = M2 + 64 * LDP; bf16_t* M4 = M3 + 64 * LDP; bf16_t* M5 = M4 + 64 * LDP;
    const int tid = ltid(), lane = tid & 63, wave = tid >> 6;
    const size_t tok0 = (size_t)b * SEQ + (size_t)n * 64;
    const size_t cidx = ((size_t)b * NCH + n) * 4 + h;
    const int jr = lane, ds8 = wave * 8;
    const int rr = tid >> 3, cs8 = (tid & 7) * 8;
    u32x4 ld_kT, ld_vT, ld_q, ld_k, ld_g; f32x4 ld_s0, ld_s1;
    ld_vT = __builtin_nontemporal_load((const u32x4*)(H + (tok0 + rr) * DINP + 512 + h * 64 + cs8));
    float wu[16];
#pragma unroll
    for (int r = 0; r < 16; ++r) wu[r] = w_up[r * 256 + h * 64 + lane];
    const float bu = b_up[h * 64 + lane];
    if (mode == 0) { ld_kT = __builtin_nontemporal_load((const u32x4*)(H + (tok0 + rr) * DINP + 256 + h * 64 + cs8)); }
    else { ld_q = __builtin_nontemporal_load((const u32x4*)(H + (tok0 + rr) * DINP + 0 + h * 64 + cs8)); ld_k = __builtin_nontemporal_load((const u32x4*)(H + (tok0 + rr) * DINP + 256 + h * 64 + cs8));
           ld_s0 = __builtin_nontemporal_load((const f32x4*)(U + cidx * 4096 + (size_t)rr * 64 + cs8)); ld_s1 = __builtin_nontemporal_load((const f32x4*)(U + cidx * 4096 + (size_t)rr * 64 + cs8 + 4));
           ld_g = __builtin_nontemporal_load((const u32x4*)(H + (tok0 + rr) * DINP + 768 + h * 64 + cs8)); }
    LR[tid] = LRB[tok0 * 16 + tid]; LR[tid + 512] = LRB[tok0 * 16 + 512 + tid];
    bf16_t* NATV = (mode == 0) ? M3 : M5; bf16_t* NATK = M2;
    *(u32x4*)(NATV + rr * LDP + cs8) = ld_vT;
    if (mode == 0) *(u32x4*)(NATK + rr * LDP + cs8) = ld_kT;
    __syncthreads();
    { const int d = lane, tg = wave; float loc[8]; float run = 0.f;
#pragma unroll
      for (int i = 0; i < 8; ++i) { const int t = tg * 8 + i; float z = bu;
#pragma unroll
          for (int r = 0; r < 16; ++r) z += LR[t * 16 + r] * wu[r];
          const float ls = fminf(z, 0.f) - __logf(1.0f + __expf(-fabsf(z)));
          run += ls * (1.0f / 16.0f); loc[i] = run; }
      TOT[tg * 64 + d] = run;
      __syncthreads();
      float off = 0.f;
      for (int g2 = 0; g2 < tg; ++g2) off += TOT[g2 * 64 + d];
#pragma unroll
      for (int i = 0; i < 8; ++i) BC[(tg * 8 + i) * 65 + d] = loc[i] + off; }
    __syncthreads();
    if (mode == 0) {
        bf16_t* KdT = M0; bf16_t* VT = M1;
        { const int d = lane, j0 = wave * 8; float kd[8]; unsigned vr[8];
#pragma unroll
          for (int e = 0; e < 8; ++e) { kd[e] = bf2f(NATK[(j0 + e) * LDP + d]) * __expf(BC[63 * 65 + d] - BC[(j0 + e) * 65 + d]); vr[e] = NATV[(j0 + e) * LDP + d]; }
          u32x4 o; o.x = pack2(kd[0], kd[1]); o.y = pack2(kd[2], kd[3]); o.z = pack2(kd[4], kd[5]); o.w = pack2(kd[6], kd[7]); *(u32x4*)(KdT + d * LDP + j0) = o;
          o.x = vr[0] | (vr[1] << 16); o.y = vr[2] | (vr[3] << 16); o.z = vr[4] | (vr[5] << 16); o.w = vr[6] | (vr[7] << 16); *(u32x4*)(VT + d * LDP + j0) = o; }
        __syncthreads();
        { const int mt = wave >> 1;
#pragma unroll
          for (int q = 0; q < 2; ++q) { const int nt = (wave & 1) * 2 + q; f32x4 acc = {0.f, 0.f, 0.f, 0.f};
              acc = mma16(VT, mt * 16, KdT, nt * 16, 2, acc, lane);
#pragma unroll
              for (int i = 0; i < 4; ++i) U[cidx * 4096 + (size_t)(mt * 16 + (lane >> 4) * 4 + i) * 64 + nt * 16 + (lane & 15)] = acc[i]; } }
        if (tid < 64) DEC[cidx * 64 + tid] = __expf(BC[63 * 65 + tid]);
        __syncthreads();
        return;
    }
    bf16_t* Qe = M0; bf16_t* Ke = M1; bf16_t* VT = M2; bf16_t* Qb = M3; bf16_t* ST = M4; bf16_t* AT = M5;
    {
      const u32x4 qw = ld_q; const u32x4 kw = ld_k;
      const unsigned qq[4] = {qw.x, qw.y, qw.z, qw.w}, kk[4] = {kw.x, kw.y, kw.z, kw.w};
      float qe[8], qb[8], ke[8];
#pragma unroll
      for (int e = 0; e < 8; ++e) { const int d = cs8 + e; const float bc = BC[rr * 65 + d], rf = BC[32 * 65 + d];
          const float qf = ((e & 1) ? bfhi(qq[e >> 1]) : bflo(qq[e >> 1])) * 0.125f, kf = (e & 1) ? bfhi(kk[e >> 1]) : bflo(kk[e >> 1]);
          qe[e] = qf * __expf(bc - rf); qb[e] = qf * __expf(bc); ke[e] = kf * __expf(rf - bc); }
      u32x4 o; o.x = pack2(qe[0], qe[1]); o.y = pack2(qe[2], qe[3]); o.z = pack2(qe[4], qe[5]); o.w = pack2(qe[6], qe[7]); *(u32x4*)(Qe + rr * LDP + cs8) = o;
      o.x = pack2(qb[0], qb[1]); o.y = pack2(qb[2], qb[3]); o.z = pack2(qb[4], qb[5]); o.w = pack2(qb[6], qb[7]); *(u32x4*)(Qb + rr * LDP + cs8) = o;
      o.x = pack2(ke[0], ke[1]); o.y = pack2(ke[2], ke[3]); o.z = pack2(ke[4], ke[5]); o.w = pack2(ke[6], ke[7]); *(u32x4*)(Ke + rr * LDP + cs8) = o;
      const f32x4 s0 = ld_s0, s1 = ld_s1;
      o.x = pack2(s0[0], s0[1]); o.y = pack2(s0[2], s0[3]); o.z = pack2(s1[0], s1[1]); o.w = pack2(s1[2], s1[3]); *(u32x4*)(ST + rr * LDP + cs8) = o;
      { const int d = lane, j0 = wave * 8; unsigned vr[8];
#pragma unroll
        for (int e = 0; e < 8; ++e) vr[e] = NATV[(j0 + e) * LDP + d];
        u32x4 ov; ov.x = vr[0] | (vr[1] << 16); ov.y = vr[2] | (vr[3] << 16); ov.z = vr[4] | (vr[5] << 16); ov.w = vr[6] | (vr[7] << 16); *(u32x4*)(VT + d * LDP + j0) = ov; } }
    __syncthreads();
    const int mt = wave >> 1, g4 = lane >> 4, r16 = lane & 15;
#pragma unroll
    for (int q = 0; q < 2; ++q) { const int nt = (wave & 1) * 2 + q; f32x4 acc = {0.f, 0.f, 0.f, 0.f};
        acc = mma16(Qe, mt * 16, Ke, nt * 16, 2, acc, lane);
#pragma unroll
        for (int i = 0; i < 4; ++i) { const int ii = mt * 16 + g4 * 4 + i, jj = nt * 16 + r16; AT[ii * LDP + jj] = f2bf(jj <= ii ? acc[i] : 0.f); } }
    __syncthreads();
#pragma unroll
    for (int q = 0; q < 2; ++q) { const int nt = (wave & 1) * 2 + q; f32x4 acc = {0.f, 0.f, 0.f, 0.f};
        acc = mma16(AT, mt * 16, VT, nt * 16, 2, acc, lane);
        acc = mma16(Qb, mt * 16, ST, nt * 16, 2, acc, lane);
#pragma unroll
        for (int i = 0; i < 4; ++i) OF[(mt * 16 + g4 * 4 + i) * 65 + nt * 16 + r16] = acc[i]; }
    __syncthreads();
    { float o[8]; float ss = 0.f;
#pragma unroll
      for (int e = 0; e < 8; ++e) { o[e] = OF[rr * 65 + cs8 + e]; ss += o[e] * o[e]; }
      ss += __shfl_xor(ss, 1, 64); ss += __shfl_xor(ss, 2, 64); ss += __shfl_xor(ss, 4, 64);
      const float rs = 1.0f / sqrtf(ss * (1.0f / 64.0f) + 1e-6f);
      const u32x4 gw = ld_g;
      const unsigned gg[4] = {gw.x, gw.y, gw.z, gw.w};
#pragma unroll
      for (int e = 0; e < 8; ++e) { const float gf = (e & 1) ? bfhi(gg[e >> 1]) : bflo(gg[e >> 1]); o[e] = o[e] * rs * norm_g[cs8 + e] * siluf_(gf); }
      u32x4 w; w.x = pack2(o[0], o[1]); w.y = pack2(o[2], o[3]); w.z = pack2(o[4], o[5]); w.w = pack2(o[6], o[7]);
      *(u32x4*)(Y + (tok0 + rr) * DM + h * 64 + cs8) = w; }
    __syncthreads();
}
__device__ __forceinline__ void scan_phase(const float* __restrict__ U, float* __restrict__ SP, const float* __restrict__ DEC, const float* __restrict__ LA, const float* __restrict__ LH, float* __restrict__ LHIN) {
    const int tid = ltid(), bid = lbid();
    if (tid < 256) {
        for (int gt = bid * 256 + tid; gt < 65536; gt += (int)gridDim.x * 256) {
            const int bh = gt >> 12, vd = gt & 4095, b = bh >> 2, h = bh & 3, d = vd & 63;
            float st = 0.f;
            const size_t c0 = ((size_t)b * NCH) * 4 + h;
            for (int n0 = 0; n0 < NCH; n0 += 16) {
                float u[16], dc[16];
#pragma unroll
                for (int j = 0; j < 16; ++j) { const size_t c = c0 + (size_t)(n0 + j) * 4; u[j] = __builtin_nontemporal_load(U + c * 4096 + vd); dc[j] = DEC[c * 64 + d]; }
#pragma unroll
                for (int j = 0; j < 16; ++j) { const size_t c = c0 + (size_t)(n0 + j) * 4; SP[c * 4096 + vd] = st; st = dc[j] * st + u[j]; }
            }
        }
    } else {
        const int e = bid * 256 + (tid - 256);
        for (int e2 = e; e2 < 1024; e2 += (int)gridDim.x * 256) {
            const int b = e2 >> 8, c = e2 & 255; float st = 0.f;
            for (int n0 = 0; n0 < NCH; n0 += 16) {
                float a[16], hh[16];
#pragma unroll
                for (int j = 0; j < 16; ++j) { const size_t idx = ((size_t)b * NCH + n0 + j) * 256 + c; a[j] = LA[idx]; hh[j] = LH[idx]; }
#pragma unroll
                for (int j = 0; j < 16; ++j) { const size_t idx = ((size_t)b * NCH + n0 + j) * 256 + c; LHIN[idx] = st; st = a[j] * st + hh[j]; }
            }
        }
    }
}

constexpr int XBP = 264;
__device__ __forceinline__ void lru_item(int mode, int b, int n, const bf16_t* H, float* LA, float* LH, const float* LHIN, bf16_t* Y,
                         const float* __restrict__ conv_w, const float* __restrict__ conv_b, const bf16_t* __restrict__ WAT  , const float* __restrict__ b_a,
                         const float* __restrict__ b_i, const float* __restrict__ lam, unsigned char* lds) {
    float* XC = (float*)lds;
    bf16_t* XCb = (bf16_t*)(lds + 65536);
    bf16_t* LG = (bf16_t*)(lds + 65536 + 64 * XBP * 2);
    const int tid = ltid(), lane = tid & 63, wave = tid >> 6, r16 = lane & 15, g4 = lane >> 4;
    const size_t tok0 = (size_t)b * SEQ + (size_t)n * 64;
    const int gblk = wave >> 1, d0 = (wave & 1) * 32;
    const int cs = tid & 31, t0 = (tid >> 5) * 4;
    bf16x8 Wf[2][2][2];
#pragma unroll
    for (int m = 0; m < 2; ++m)
#pragma unroll
        for (int nt = 0; nt < 2; ++nt)
#pragma unroll
            for (int ks = 0; ks < 2; ++ks) Wf[m][nt][ks] = *(const bf16x8*)(WAT + (size_t)(((((m * 4 + gblk) * 2 + (wave & 1)) * 2 + nt) * 2 + ks) * 512 + lane * 8));
    u32x4 xr[7], gr[4];
#pragma unroll
    for (int j = 0; j < 7; ++j) { const int tk = t0 - 3 + j;
        xr[j] = (n > 0 || tk >= 0) ? __builtin_nontemporal_load((const u32x4*)(H + (size_t)((long)tok0 + tk) * DINP + 2560 + cs * 8)) : (u32x4){0u, 0u, 0u, 0u}; }
    if (mode == 1) {
#pragma unroll
        for (int tt = 0; tt < 4; ++tt) gr[tt] = __builtin_nontemporal_load((const u32x4*)(H + (tok0 + t0 + tt) * DINP + 2816 + cs * 8)); }
    f32x4 cw[4][2], cbv[2];
#pragma unroll
    for (int w = 0; w < 4; ++w) { cw[w][0] = *(const f32x4*)(conv_w + w * 256 + cs * 8); cw[w][1] = *(const f32x4*)(conv_w + w * 256 + cs * 8 + 4); }
    cbv[0] = *(const f32x4*)(conv_b + cs * 8); cbv[1] = *(const f32x4*)(conv_b + cs * 8 + 4);
#pragma unroll
    for (int tt = 0; tt < 4; ++tt) { float xc[8];
#pragma unroll
        for (int e2 = 0; e2 < 8; ++e2) { float acc = cbv[e2 >> 2][e2 & 3];
#pragma unroll
            for (int w = 0; w < 4; ++w) { const unsigned wd = xr[tt + w][e2 >> 1]; acc += cw[w][e2 >> 2][e2 & 3] * ((e2 & 1) ? bfhi(wd) : bflo(wd)); }
            xc[e2] = acc; }
        *(f32x4*)(XC + (t0 + tt) * 256 + cs * 8) = (f32x4){xc[0], xc[1], xc[2], xc[3]}; *(f32x4*)(XC + (t0 + tt) * 256 + cs * 8 + 4) = (f32x4){xc[4], xc[5], xc[6], xc[7]};
        u32x4 o; o.x = pack2(xc[0], xc[1]); o.y = pack2(xc[2], xc[3]); o.z = pack2(xc[4], xc[5]); o.w = pack2(xc[6], xc[7]);
        *(u32x4*)(XCb + (t0 + tt) * XBP + cs * 8) = o;
        if (mode == 1) *(u32x4*)(LG + (t0 + tt) * XBP + cs * 8) = gr[tt]; }
    __syncthreads();
    f32x4 R[4][2], I[4][2];
#pragma unroll
    for (int mt = 0; mt < 4; ++mt) {
        const bf16x8 a0 = *(const bf16x8*)(XCb + (mt * 16 + r16) * XBP + gblk * 64 + g4 * 8), a1 = *(const bf16x8*)(XCb + (mt * 16 + r16) * XBP + gblk * 64 + 32 + g4 * 8);
#pragma unroll
        for (int nt = 0; nt < 2; ++nt) { f32x4 z = {0.f, 0.f, 0.f, 0.f};
            z = __builtin_amdgcn_mfma_f32_16x16x32_bf16(a0, Wf[0][nt][0], z, 0, 0, 0); R[mt][nt] = __builtin_amdgcn_mfma_f32_16x16x32_bf16(a1, Wf[0][nt][1], z, 0, 0, 0);
            f32x4 y = {0.f, 0.f, 0.f, 0.f};
            y = __builtin_amdgcn_mfma_f32_16x16x32_bf16(a0, Wf[1][nt][0], y, 0, 0, 0); I[mt][nt] = __builtin_amdgcn_mfma_f32_16x16x32_bf16(a1, Wf[1][nt][1], y, 0, 0, 0); } }
#pragma unroll
    for (int nt = 0; nt < 2; ++nt) {
        const int ch = wave * 32 + nt * 16 + r16;
        const float ba = b_a[ch], bi = b_i[ch];
        const float ey = __expf(-lam[ch]); const float sp = (ey < 0.03f) ? ey * (1.0f - ey * (0.5f - ey * (0.33333333f - 0.25f * ey))) : __logf(1.0f + ey);
        const float csp = -8.0f * 1.4426950408889634f * sp;
        float Am[4], Hm[4];
#pragma unroll
        for (int mt = 0; mt < 4; ++mt) { float am = 1.f, hm = 0.f;
#pragma unroll
            for (int i = 0; i < 4; ++i) {
                const float d1 = 1.0f + __builtin_amdgcn_exp2f(fminf(-1.4426950408889634f * (R[mt][nt][i] + ba), 60.f)), d2 = 1.0f + __builtin_amdgcn_exp2f(fminf(-1.4426950408889634f * (I[mt][nt][i] + bi), 60.f));
                const float inv = __builtin_amdgcn_rcpf(d1 * d2); const float r = inv * d2, ig = inv * d1;
                const float a = __builtin_amdgcn_exp2f(csp * r); const float u = sqrtf(fmaf(-a, a, 1.0f)) * ig * XC[(mt * 16 + g4 * 4 + i) * 256 + ch];
                R[mt][nt][i] = a; I[mt][nt][i] = u; am *= a; hm = a * hm + u; }
            Am[mt] = am; Hm[mt] = hm; }
        const size_t aidx = ((size_t)b * NCH + n) * 256 + ch;
        if (mode == 0) {
            float cA = 1.f, cH = 0.f;
#pragma unroll
            for (int mt = 0; mt < 4; ++mt)
#pragma unroll
                for (int src = 0; src < 4; ++src) { const float As = __shfl(Am[mt], src * 16 + r16, 64), Hs = __shfl(Hm[mt], src * 16 + r16, 64); cH = As * cH + Hs; cA *= As; }
            if (g4 == 0) { LA[aidx] = cA; LH[aidx] = cH; }
        } else {
            float st = LHIN[aidx];
#pragma unroll
            for (int mt = 0; mt < 4; ++mt) { float sin_ = st;
#pragma unroll
                for (int src = 0; src < 4; ++src) { const float As = __shfl(Am[mt], src * 16 + r16, 64), Hs = __shfl(Hm[mt], src * 16 + r16, 64);
                    const float cand = As * sin_ + Hs; sin_ = (src < g4) ? cand : sin_; st = As * st + Hs; }
#pragma unroll
                for (int i = 0; i < 4; ++i) { sin_ = R[mt][nt][i] * sin_ + I[mt][nt][i]; const int t = mt * 16 + g4 * 4 + i;
                    const float gt = bf2f(LG[t * XBP + ch]); LG[t * XBP + ch] = f2bf(sin_ * gelu_tanh(gt)); } }
        }
    }
    __syncthreads();
    if (mode == 1) {
#pragma unroll
        for (int tt = 0; tt < 4; ++tt) *(u32x4*)(Y + (tok0 + t0 + tt) * DM + 768 + cs * 8) = *(const u32x4*)(LG + (t0 + tt) * XBP + cs * 8);
        __syncthreads();
    }
}

__device__ __forceinline__ void attn_item(int b, int n, int hg, const bf16_t* H, const bf16_t* vT, const bf16_t* KP, bf16_t* Y, const float* __restrict__ rel_bias, unsigned char* lds, int probe = 0, int never = 0) {
    const int tid = ltid(), lane = tid & 63, wv = tid >> 6, h = hg * 4 + (wv & 3), qh = wv >> 2, r16 = lane & 15, g4 = lane >> 4;
    const float* BT = (const float*)(lds + LDS_BT_OFF) + h * 520;
    const size_t tok0 = (size_t)b * SEQ + (size_t)n * 64;
    const int kb0 = (n >= 8) ? 0 : 8 - n;
    const float bfar = BT[512];
    bf16_t* WL = (bf16_t*)lds + wv * (32 * LDP);
    bf16x8 Qf[2][2];
    { u32x4 qw[4];
#pragma unroll
      for (int k = 0; k < 4; ++k) qw[k] = __builtin_nontemporal_load((const u32x4*)(H + (tok0 + qh * 32 + (lane >> 3) + 8 * k) * DINP + 1024 + h * 64 + (lane & 7) * 8));
#pragma unroll
      for (int k = 0; k < 4; ++k) *(u32x4*)(WL + ((lane >> 3) + 8 * k) * LDP + (lane & 7) * 8) = qw[k];
      asm volatile("s_waitcnt lgkmcnt(0)" ::: "memory"); __builtin_amdgcn_wave_barrier();
#pragma unroll
      for (int mt = 0; mt < 2; ++mt)
#pragma unroll
          for (int ks = 0; ks < 2; ++ks) Qf[mt][ks] = *(const bf16x8*)(WL + (mt * 16 + r16) * LDP + ks * 32 + g4 * 8);
      asm volatile("s_waitcnt lgkmcnt(0)" ::: "memory"); __builtin_amdgcn_wave_barrier(); }
    f32x4 OT[2][4]; float mrow[2], lrow[2];
#pragma unroll
    for (int mt = 0; mt < 2; ++mt) { mrow[mt] = -1e30f; lrow[mt] = 0.f;
#pragma unroll
        for (int dt = 0; dt < 4; ++dt) OT[mt][dt] = (f32x4){0.f, 0.f, 0.f, 0.f}; }
    bf16x8 Kf[4][2], Vf[4][2];
    const bf16_t* vrow = vT + ((size_t)b * NCH * 8 + h) * 4096 + lane * 8;
    const bf16_t* krow = KP + ((size_t)b * NCH * 8 + h) * 4096 + lane * 8;
    { const size_t kc = (size_t)(n - 8 + kb0) * 32768;
#pragma unroll
      for (int kt = 0; kt < 4; ++kt)
#pragma unroll
          for (int ks = 0; ks < 2; ++ks) Kf[kt][ks] = *(const bf16x8*)(krow + kc + (kt * 2 + ks) * 512);
#pragma unroll
      for (int dt = 0; dt < 4; ++dt)
#pragma unroll
          for (int j = 0; j < 2; ++j) Vf[dt][j] = *(const bf16x8*)(vrow + kc + (dt * 2 + j) * 512); }
    for (int kb = kb0; kb < 9; ++kb) {
        const int kbn = (kb + 1 < 9) ? kb + 1 : kb;
        const size_t kcn = (size_t)(n - 8 + (probe ? kb0 : kbn)) * 32768;
        f32x4 ST[4][2];
#pragma unroll
        for (int kt = 0; kt < 4; ++kt)
#pragma unroll
            for (int mt = 0; mt < 2; ++mt) { f32x4 a = {0.f, 0.f, 0.f, 0.f};
                a = __builtin_amdgcn_mfma_f32_16x16x32_bf16(Kf[kt][0], Qf[mt][0], a, 0, 0, 0);
                a = __builtin_amdgcn_mfma_f32_16x16x32_bf16(Kf[kt][1], Qf[mt][1], a, 0, 0, 0); ST[kt][mt] = a; }
        __builtin_amdgcn_sched_barrier(0);
#pragma unroll
        for (int kt = 0; kt < 4; ++kt)
#pragma unroll
            for (int ks = 0; ks < 2; ++ks) Kf[kt][ks] = *(const bf16x8*)(krow + kcn + (kt * 2 + ks) * 512);
        __builtin_amdgcn_sched_barrier(0);
        bf16x8 Pf[2][2];
#pragma unroll
        for (int mt = 0; mt < 2; ++mt) {
            float mx = -1e30f;
            constexpr float SC = 0.125f * 1.4426950408889634f;
            if (kb <= 3) {
#pragma unroll
                for (int kt = 0; kt < 4; ++kt)
#pragma unroll
                    for (int i = 0; i < 4; ++i) { const float s = ST[kt][mt][i] * SC + bfar; ST[kt][mt][i] = s; mx = fmaxf(mx, s); }
            } else {
                const int c0 = qh * 32 + mt * 16 + r16 - g4 * 4 + (8 - kb) * 64 + 256;
                if (kb == 4) {
#pragma unroll
                    for (int kt = 0; kt < 4; ++kt)
#pragma unroll
                        for (int i = 0; i < 4; ++i) { int idx = c0 - kt * 16 - i; idx = idx > 512 ? 512 : idx;
                            const float s = ST[kt][mt][i] * SC + BT[idx]; ST[kt][mt][i] = s; mx = fmaxf(mx, s); }
                } else {
                    const float* bp = BT + (c0 - 63);
#pragma unroll
                    for (int kt = 0; kt < 4; ++kt)
#pragma unroll
                        for (int i = 0; i < 4; ++i) { const float s = ST[kt][mt][i] * SC + bp[63 - kt * 16 - i]; ST[kt][mt][i] = s; mx = fmaxf(mx, s); }
                }
            }
            mx = fmaxf(mx, __shfl_xor(mx, 16, 64)); mx = fmaxf(mx, __shfl_xor(mx, 32, 64));
            const float mnew = fmaxf(mrow[mt], mx), alpha = __builtin_amdgcn_exp2f(mrow[mt] - mnew);
            float ps = 0.f;
#pragma unroll
            for (int kt = 0; kt < 4; ++kt)
#pragma unroll
                for (int i = 0; i < 4; ++i) { const float pv = __builtin_amdgcn_exp2f(ST[kt][mt][i] - mnew); ST[kt][mt][i] = pv; ps += pv; }
            lrow[mt] = lrow[mt] * alpha + ps; mrow[mt] = mnew;
#pragma unroll
            for (int dt = 0; dt < 4; ++dt) OT[mt][dt] = OT[mt][dt] * alpha;
#pragma unroll
            for (int j = 0; j < 2; ++j) { u32x4 w;
                w.x = pg8::cvt_pk_bf16(ST[2 * j][mt][0], ST[2 * j][mt][1]); w.y = pg8::cvt_pk_bf16(ST[2 * j][mt][2], ST[2 * j][mt][3]);
                w.z = pg8::cvt_pk_bf16(ST[2 * j + 1][mt][0], ST[2 * j + 1][mt][1]); w.w = pg8::cvt_pk_bf16(ST[2 * j + 1][mt][2], ST[2 * j + 1][mt][3]);
                Pf[mt][j] = __builtin_bit_cast(bf16x8, w); }
        }
#pragma unroll
        for (int dt = 0; dt < 4; ++dt)
#pragma unroll
            for (int j = 0; j < 2; ++j) { const bf16x8 vf = Vf[dt][j];
#pragma unroll
                for (int mt = 0; mt < 2; ++mt) OT[mt][dt] = __builtin_amdgcn_mfma_f32_16x16x32_bf16(vf, Pf[mt][j], OT[mt][dt], 0, 0, 0); }
        __builtin_amdgcn_sched_barrier(0);
#pragma unroll
        for (int dt = 0; dt < 4; ++dt)
#pragma unroll
            for (int j = 0; j < 2; ++j) Vf[dt][j] = *(const bf16x8*)(vrow + kcn + (dt * 2 + j) * 512);
        __builtin_amdgcn_sched_barrier(0);
    }
#pragma unroll
    for (int mt = 0; mt < 2; ++mt) { float l = lrow[mt]; l += __shfl_xor(l, 16, 64); l += __shfl_xor(l, 32, 64);
        const float inv = 1.0f / l;
#pragma unroll
        for (int dt = 0; dt < 4; ++dt) { u32x2 w; w.x = pg8::cvt_pk_bf16(OT[mt][dt][0] * inv, OT[mt][dt][1] * inv); w.y = pg8::cvt_pk_bf16(OT[mt][dt][2] * inv, OT[mt][dt][3] * inv);
            *(u32x2*)(WL + (mt * 16 + r16) * LDP + dt * 16 + g4 * 4) = w; } }
    asm volatile("s_waitcnt lgkmcnt(0)" ::: "memory"); __builtin_amdgcn_wave_barrier();
    if (!probe || never) {
#pragma unroll
        for (int k = 0; k < 4; ++k) { const int row = (lane >> 3) + 8 * k; const u32x4 v = *(const u32x4*)(WL + row * LDP + (lane & 7) * 8);
            *(u32x4*)(Y + (tok0 + qh * 32 + row) * DM + 256 + h * 64 + (lane & 7) * 8) = v; } }
    asm volatile("s_waitcnt lgkmcnt(0)" ::: "memory"); __builtin_amdgcn_wave_barrier();
}

#ifndef DUPMASK
#define DUPMASK 0
#endif
#define GSYNC() do { xcd_barrier(xbar); if (DUPMASK & 512) xcd_barrier(xbar); } while (0)
struct Ptrs { unsigned char* ws; bf16_t* XB; bf16_t* PB; bf16_t* R1; float* X1; bf16_t* VT; float* U; float* SP; bf16_t* KP; float* ST1; float* ST2; float* LRB; float* DEC; float* LA; float* LH; float* LHIN; };
__device__ __forceinline__ Ptrs mkptrs(const Params& p) { Ptrs q; unsigned char* ws = p.ws; q.ws = ws;
    q.XB = (bf16_t*)(ws + WS_XB); q.PB = (bf16_t*)(ws + WS_PB); q.R1 = (bf16_t*)(ws + WS_R1); q.X1 = (float*)(ws + WS_X1); unsigned char* ob = (unsigned char*)p.out; q.VT = (bf16_t*)(ob + X1_VT); q.U = (float*)(ob + X1_U); q.SP = (float*)(ob + X1_SP); q.KP = (bf16_t*)(ob + X1_KP); q.ST1 = (float*)(ws + WS_ST); q.ST2 = q.ST1 + 2 * T_TOK; q.LRB = (float*)(ws + WS_LRB);
    q.DEC = (float*)(ws + WS_SM); q.LA = q.DEC + 131072; q.LH = q.LA + 131072; q.LHIN = q.LH + 131072; return q; }

__global__ void __launch_bounds__(512, 2) fwd_megakernel(Params p_unused) {
    extern __shared__ __attribute__((aligned(16))) unsigned char lds[];
    cg::grid_group grid = cg::this_grid();
    { volatile LAS unsigned* st = (volatile LAS unsigned*)((LAS unsigned char*)lds + LDS_BAR_OFF);
      if (threadIdx.x < 4) st[threadIdx.x] = 0u; }
    __syncthreads();
    XcdBarrier xbar;
    { const Params p = fresh_params(); xbar = xcd_barrier_post((unsigned*)(p.ws + WS_BAR), (volatile LAS unsigned*)((LAS unsigned char*)lds + LDS_BAR_OFF)); }
    for (int rep_ = 0; rep_ < ((DUPMASK & 8192) ? 2 : 1); ++rep_) { const Params p = fresh_params(); prologue_phase(p, lds); }
    if (p_unused.ws == nullptr) grid.sync();
    xcd_barrier(xbar);

#pragma unroll 1
    for (int l = 0; l < 2; ++l) {
        for (int rep_ = 0; rep_ < ((DUPMASK & 257) ? 2 : 1); ++rep_) { const Params p = fresh_params(); const Ptrs q = mkptrs(p);
          EpiStoreBf16 E; E.O = q.R1; E.ldc = DINP; run_gemm(lds, q.XB, (const bf16_t*)(q.ws + WS_WIN + l * SZ_WIN), 3072, DM, E);
          for (int c = lbid(); c < T_TOK / 64; c += gridDim.x) glr_item(c, q.XB, (const bf16_t*)(q.ws + WS_WIN + l * SZ_WIN) + (size_t)3072 * DM, q.LRB, lds); }
        GSYNC();
        for (int rep_ = 0; rep_ < ((DUPMASK & 2) ? 2 : 1); ++rep_) { const Params p = fresh_params(); const Ptrs q = mkptrs(p); const int G = gridDim.x;
          for (int it = lbid(); it < 3072; it += G) {
            if (it < 512) for (int r2 = 0; r2 < ((DUPMASK & 32) ? 2 : 1); ++r2) lru_item(0, it >> 7, it & 127, q.R1, q.LA, q.LH, q.LHIN, q.XB, p.in[7] + l * 1024, p.in[8] + l * 256, (const bf16_t*)(q.ws + WS_WLRU) + (size_t)l * 32768, p.in[10] + l * 256, p.in[12] + l * 256, p.in[13] + l * 256, lds);
            else if (it < 2560) for (int r2 = 0; r2 < ((DUPMASK & 64) ? 2 : 1); ++r2) { const int e = it - 512; gla_item(0, e >> 9, (e >> 2) & 127, e & 3, q.R1, q.LRB, q.U, q.DEC, q.XB, p.in[3] + l * 4096, p.in[4] + l * 256, p.in[5] + l * 64, lds); }
            else for (int r2 = 0; r2 < ((DUPMASK & 128) ? 2 : 1); ++r2) { const int e = it - 2560; vtrans_item(e >> 7, e & 127, q.R1, q.VT, q.KP, lds); }
          } }
        GSYNC();
        for (int rep_ = 0; rep_ < ((DUPMASK & 4) ? 2 : 1); ++rep_) { const Params p = fresh_params(); const Ptrs q = mkptrs(p); scan_phase(q.U, q.SP, q.DEC, q.LA, q.LH, q.LHIN); }
        GSYNC();
        { const Params p = fresh_params(); const int t = ltid(); float* bt = (float*)(lds + LDS_BT_OFF); float v[9];
#pragma unroll
          for (int i = 0; i < 9; ++i) { const int e = t + 512 * i; v[i] = (e < 8 * 513) ? p.in[6][e] : 0.f; }
#pragma unroll
          for (int i = 0; i < 9; ++i) { const int e = t + 512 * i; if (e < 8 * 513) bt[(e / 513) * 520 + (e % 513)] = v[i] * 1.4426950408889634f; }
          __syncthreads(); }
        for (int rep_ = 0; rep_ < ((DUPMASK & 2) ? 2 : 1); ++rep_) { const Params p = fresh_params(); const Ptrs q = mkptrs(p); const int G = gridDim.x;
          for (int it = lbid(); it < 3584; it += G) {
            if (it < 1024) for (int r2 = 0; r2 < ((DUPMASK & 16) ? 2 : 1); ++r2) { const int sl = (it & 255) >> 3; const int ai = (G == 256) ? ((it & 7) * 64 + (it >> 8) * 16 + (sl >> 1)) : (it >> 1); const int hg = (G == 256) ? (sl & 1) : (it & 1); attn_item(ai >> 7, ai & 127, hg, q.R1, q.VT, q.KP, q.XB, p.in[6], lds, (DUPMASK & 1024) ? r2 : 0, l > 100); }
            else if (it < 1536) for (int r2 = 0; r2 < ((DUPMASK & 32) ? 2 : 1); ++r2) { const int e = it - 1024; __syncthreads();     lru_item(1, e >> 7, e & 127, q.R1, q.LA, q.LH, q.LHIN, q.XB, p.in[7] + l * 1024, p.in[8] + l * 256, (const bf16_t*)(q.ws + WS_WLRU) + (size_t)l * 32768, p.in[10] + l * 256, p.in[12] + l * 256, p.in[13] + l * 256, lds); }
            else for (int r2 = 0; r2 < ((DUPMASK & 64) ? 2 : 1); ++r2) { const int e = it - 1536; gla_item(1, e >> 9, (e >> 2) & 127, e & 3, q.R1, q.LRB, q.SP, q.DEC, q.XB, p.in[3] + l * 4096, p.in[4] + l * 256, p.in[5] + l * 64, lds); }
          } }
        GSYNC();
        for (int rep_ = 0; rep_ < (((DUPMASK & 1) && l == 0) ? 2 : 1); ++rep_) { const Params p = fresh_params(); const Ptrs q = mkptrs(p);
          if (l == 0) { EpiF32<0> E; E.C = q.X1; E.R = p.in[0]; E.P = nullptr; E.ST = nullptr; E.g = nullptr; E.b = nullptr; run_gemm(lds, q.XB, (const bf16_t*)(q.ws + WS_WOUT + l * SZ_WOUT), DM, DM, E); }
          else { EpiF32<4> E; E.C = q.X1; E.R = nullptr; E.P = nullptr; E.ST = q.ST2; E.g = p.in[22]; E.b = p.in[23]; run_gemm(lds, q.XB, (const bf16_t*)(q.ws + WS_WOUT + l * SZ_WOUT), DM, DM, E); } }
        GSYNC();
        for (int rep_ = 0; rep_ < ((DUPMASK & 2048) ? 2 : 1); ++rep_) { const Params p = fresh_params(); const Ptrs q = mkptrs(p);
          ln_phase(q.X1, nullptr, q.XB, q.ST1, p.in[15] + l * DM, p.in[16] + l * DM);
          cvt_rows_bf16(p.in[1] + (size_t)l * T_TOK * PLE, q.PB, (size_t)T_TOK * PLE / 8); }
        GSYNC();
        for (int rep_ = 0; rep_ < ((DUPMASK & 4096) ? 2 : 1); ++rep_) { const Params p = fresh_params(); const Ptrs q = mkptrs(p);
          EpiGUPG E; E.O = q.R1; E.PL = p.out; run_gemm(lds, q.XB, (const bf16_t*)(q.ws + WS_WGU + l * SZ_WGU), 2 * DFF + DM, DM, E); }
        GSYNC();
        for (int rep_ = 0; rep_ < ((DUPMASK & 16384) ? 2 : 1); ++rep_) {
        { const Params p = fresh_params(); const Ptrs q = mkptrs(p);
          EpiF32<2> E; E.nostore = ((DUPMASK & 16384) && rep_ == 0) ? 1 : 0; E.PPB = q.XB; E.C = nullptr; E.R = nullptr; E.P = nullptr; E.ST = nullptr; E.g = nullptr; E.b = nullptr; run_gemm(lds, q.PB, (const bf16_t*)(q.ws + WS_WPP + l * SZ_WPP), DM, PLE, E); }
        { const Params p = fresh_params(); const Ptrs q = mkptrs(p);
          EpiF32<5> E; E.nostore = ((DUPMASK & 16384) && rep_ == 0) ? 1 : 0; E.PPB = q.XB; E.C = q.X1; E.R = nullptr; E.P = p.out; E.ST = q.ST1; E.g = p.in[15] + l * DM; E.b = p.in[16] + l * DM; run_gemm(lds, q.R1, (const bf16_t*)(q.ws + WS_WDN + l * SZ_WDN), DM, DFF, E); } }
        GSYNC();
        for (int rep_ = 0; rep_ < ((DUPMASK & 8) ? 2 : 1); ++rep_) { const Params p = fresh_params(); const Ptrs q = mkptrs(p);
          if (l == 0) ln_phase(q.X1, nullptr, q.XB, q.ST2, p.in[22], p.in[23]);
          else ln_phase(q.X1, p.out, nullptr, nullptr, p.in[22] + DM, p.in[23] + DM); }
        if (l == 0) GSYNC();
    }
}

extern "C" void kernel_launch(void* const* d_in, const int* in_sizes, int n_in, void* d_out, int out_size, void* d_ws, size_t ws_size, hipStream_t stream) {
    constexpr int kLds = LDS_BT_OFF + 8 * 520 * 4;
    static int grid_blocks = 0;
    if (grid_blocks == 0) {
        if (n_in != 24 || out_size != T_TOK * DM || ws_size < WS_END) { fprintf(stderr, "kernel_launch: unexpected shapes (n_in %d out %d ws %zu need %zu)\n", n_in, out_size, ws_size, (size_t)WS_END); grid_blocks = -1; return; }
        int dev = 0, cus = 0, per_cu = 0;
        hipGetDevice(&dev);
        hipDeviceGetAttribute(&cus, hipDeviceAttributeMultiprocessorCount, dev);
        if (hipFuncSetAttribute((const void*)fwd_megakernel, hipFuncAttributeMaxDynamicSharedMemorySize, kLds) != hipSuccess) { fprintf(stderr, "kernel_launch: hipFuncSetAttribute failed\n"); grid_blocks = -1; return; }
        if (hipOccupancyMaxActiveBlocksPerMultiprocessor(&per_cu, (const void*)fwd_megakernel, 512, kLds) != hipSuccess || per_cu < 1) { fprintf(stderr, "kernel_launch: occupancy query says %d\n", per_cu); per_cu = 1; (void)hipGetLastError(); }
        if (per_cu > 1) per_cu = 1;
        grid_blocks = cus * per_cu;
    }
    if (grid_blocks < 0) return;
    if (hipMemsetAsync((unsigned char*)d_ws + WS_BAR, 0, XCD_BAR_WORDS * 4, stream) != hipSuccess) { fprintf(stderr, "kernel_launch: memset of the barrier words failed\n"); return; }
    Params p{};
    for (int i = 0; i < 24; ++i) p.in[i] = (const float*)d_in[i];
    p.out = (float*)d_out; p.ws = (unsigned char*)d_ws;
    void* args[] = {&p};
    hipError_t e = hipLaunchCooperativeKernel((const void*)fwd_megakernel, dim3(grid_blocks), dim3(512), args, kLds, stream);
    if (e != hipSuccess) fprintf(stderr, "cooperative launch failed: %s (grid %d)\n", hipGetErrorString(e), grid_blocks);
}
```
